# Optimizing an MI355X kernel written in HIP

```python
import jax, jax.numpy as jnp
from jax import lax
import numpy as np


D_MODEL = 1024
BATCH = 8
SEQ = 2048
DEPTH = 2

M_HEADS = 4
M_DQK = 128
M_DV = 256
CONV_K = 4
R_HEADS = 4
R_DQK = 128
R_DV = 256
CHUNK = 128
ROPE_BASE = 10000.0
N_GROUPS = 4
EXPERTS_PER_GROUP = 4
N_EXPERTS = N_GROUPS * EXPERTS_PER_GROUP
TOP_K = 2
D_FF_EXPERT = 512
EPS = 1e-6
MAX_POS_OFFSET = 1024

M_QK_W = M_HEADS * M_DQK
M_V_W = M_HEADS * M_DV
R_QK_W = R_HEADS * R_DQK
R_V_W = R_HEADS * R_DV
IN_SPLITS = (M_QK_W, M_QK_W, M_V_W, M_V_W, M_HEADS, M_HEADS, R_QK_W, R_QK_W, R_V_W, R_V_W, D_MODEL, D_MODEL)
D_IN = 2 * M_QK_W + 2 * M_V_W + 2 * M_HEADS + 2 * R_QK_W + 2 * R_V_W + 2 * D_MODEL

kernel_name = 'hybrid_mlstm_retention_hmoe_block'


def rms_norm(x, gain):
    xf = x.astype(jnp.float32)
    var = jnp.mean(xf * xf, axis=-1, keepdims=True)
    return (xf * lax.rsqrt(var + EPS)).astype(x.dtype) * gain


def split_cols(t, sizes):
    out, start = [], 0
    for s in sizes:
        out.append(t[..., start:start + s])
        start += s
    return out


def to_heads(t, n_heads):
    B, S, W = t.shape
    return jnp.swapaxes(t.astype(jnp.float32).reshape(B, S, n_heads, W // n_heads), 1, 2)


def causal_dwconv(x, w, b):
    C = x.shape[-1]
    y = lax.conv_general_dilated(x, w[:, None, :].astype(x.dtype), window_strides=(1,),
                                 padding=[(CONV_K - 1, 0)],
                                 dimension_numbers=('NWC', 'WIO', 'NWC'),
                                 feature_group_count=C)
    return y + b


def rotary(x, positions):
    d = x.shape[-1]
    inv = ROPE_BASE ** (-jnp.arange(0, d, 2, dtype=jnp.float32) / d)
    ang = positions.astype(jnp.float32)[..., None] * inv
    cos = jnp.cos(ang)[:, :, None, :]
    sin = jnp.sin(ang)[:, :, None, :]
    x1, x2 = x[..., : d // 2], x[..., d // 2:]
    return jnp.concatenate([x1 * cos - x2 * sin, x1 * sin + x2 * cos], axis=-1)


def mlstm_chunkwise(q, k, v, i_pre, f_pre):
    B, H, S, dk = q.shape
    dv = v.shape[-1]
    L = CHUNK
    NC = S // L
    q = q.reshape(B, H, NC, L, dk)
    k = k.reshape(B, H, NC, L, dk) * (dk ** -0.5)
    v = v.reshape(B, H, NC, L, dv)
    ig = i_pre.reshape(B, H, NC, L)
    lf = jax.nn.log_sigmoid(f_pre).reshape(B, H, NC, L)
    b = jnp.cumsum(lf, axis=-1)
    b_tot = b[..., -1]
    a = b_tot[..., None] - b + ig

    def step(carry, xs):
        C, n, m = carry
        bt, a_c, k_c, v_c = xs
        m_new = jnp.maximum(bt + m, jnp.max(a_c, axis=-1))
        decay = jnp.exp(bt + m - m_new)
        w = jnp.exp(a_c - m_new[..., None])
        C_new = decay[..., None, None] * C + jnp.einsum('bhl,bhld,bhle->bhde', w, k_c, v_c)
        n_new = decay[..., None] * n + jnp.einsum('bhl,bhld->bhd', w, k_c)
        return (C_new, n_new, m_new), (C, n, m)

    init = (jnp.zeros((B, H, dk, dv), jnp.float32), jnp.zeros((B, H, dk), jnp.float32),
            jnp.zeros((B, H), jnp.float32))
    xs = (jnp.moveaxis(b_tot, 2, 0), jnp.moveaxis(a, 2, 0), jnp.moveaxis(k, 2, 0), jnp.moveaxis(v, 2, 0))
    _, (C_st, n_st, m_st) = lax.scan(step, init, xs)
    C_st = jnp.moveaxis(C_st, 0, 2)
    n_st = jnp.moveaxis(n_st, 0, 2)
    m_st = jnp.moveaxis(m_st, 0, 2)

    causal = jnp.tril(jnp.ones((L, L), dtype=bool))
    log_d = jnp.where(causal, b[..., :, None] - b[..., None, :] + ig[..., None, :], -jnp.inf)
    log_inter = b + m_st[..., None]
    m_t = jnp.maximum(log_inter, jnp.max(log_d, axis=-1))
    d_mat = jnp.exp(log_d - m_t[..., None])
    s = jnp.einsum('bhcld,bhcsd->bhcls', q, k) * d_mat
    inter_w = jnp.exp(log_inter - m_t)
    num = jnp.einsum('bhcls,bhcse->bhcle', s, v) + inter_w[..., None] * jnp.einsum('bhcld,bhcde->bhcle', q, C_st)
    den = jnp.sum(s, axis=-1) + inter_w * jnp.einsum('bhcld,bhcd->bhcl', q, n_st)
    h = num / jnp.maximum(jnp.abs(den), jnp.exp(-m_t))[..., None]
    return h.reshape(B, H, S, dv)


def retention_chunkwise(q, k, v):
    B, H, S, dk = q.shape
    dv = v.shape[-1]
    L = CHUNK
    NC = S // L
    log_g = jnp.log(1.0 - 2.0 ** (-5.0 - jnp.arange(H, dtype=jnp.float32)))
    q = q.reshape(B, H, NC, L, dk)
    k = k.reshape(B, H, NC, L, dk) * (dk ** -0.5)
    v = v.reshape(B, H, NC, L, dv)
    idx = jnp.arange(L, dtype=jnp.float32)
    rel = idx[:, None] - idx[None, :]
    causal = rel >= 0
    d_mat = jnp.where(causal, jnp.exp(log_g[:, None, None] * jnp.where(causal, rel, 0.0)), 0.0)
    s = jnp.einsum('bhcld,bhcsd->bhcls', q, k) * d_mat[None, :, None]
    inner = jnp.einsum('bhcls,bhcse->bhcle', s, v)
    xi = jnp.exp(log_g[:, None] * (idx + 1.0))
    zeta = jnp.exp(log_g[:, None] * (L - 1.0 - idx))
    chunk_gamma = jnp.exp(log_g * L)
    kv = jnp.einsum('hs,bhcsd,bhcse->bhcde', zeta, k, v)

    def step(R, kv_c):
        return chunk_gamma[None, :, None, None] * R + kv_c, R

    _, R_st = lax.scan(step, jnp.zeros((B, H, dk, dv), jnp.float32), jnp.moveaxis(kv, 2, 0))
    R_st = jnp.moveaxis(R_st, 0, 2)
    cross = jnp.einsum('bhcld,bhcde->bhcle', q, R_st) * xi[None, :, None, :, None]
    return (inner + cross).reshape(B, H, S, dv)


def hybrid_mixer(h, positions, w_in, conv_w, conv_b, m_ig_b, m_fg_b, m_norm_g, r_norm_g, w_bm, w_br, w_out):
    B, S, _ = h.shape
    f32 = jnp.float32
    proj = h @ w_in
    mq, mk, mv, mo, mi, mf, rq, rk, rv, rg, ga, gb = split_cols(proj, IN_SPLITS)
    qk = jax.nn.silu(causal_dwconv(jnp.concatenate([mq, mk], axis=-1), conv_w, conv_b))
    mq, mk = qk[..., :M_QK_W], qk[..., M_QK_W:]
    hm = mlstm_chunkwise(to_heads(mq, M_HEADS), to_heads(mk, M_HEADS), to_heads(mv, M_HEADS),
                         jnp.swapaxes((mi + m_ig_b).astype(f32), 1, 2),
                         jnp.swapaxes((mf + m_fg_b).astype(f32), 1, 2))
    hm = rms_norm(jnp.swapaxes(hm, 1, 2), m_norm_g) * jax.nn.sigmoid(mo.astype(f32).reshape(B, S, M_HEADS, M_DV))
    ym = hm.reshape(B, S, M_V_W).astype(h.dtype)
    rq = rotary(rq.astype(f32).reshape(B, S, R_HEADS, R_DQK), positions)
    rk = rotary(rk.astype(f32).reshape(B, S, R_HEADS, R_DQK), positions)
    hr = retention_chunkwise(jnp.swapaxes(rq, 1, 2), jnp.swapaxes(rk, 1, 2), to_heads(rv, R_HEADS))
    hr = rms_norm(jnp.swapaxes(hr, 1, 2), r_norm_g) * jax.nn.silu(rg.astype(f32).reshape(B, S, R_HEADS, R_DV))
    yr = hr.reshape(B, S, R_V_W).astype(h.dtype)
    y = jax.nn.sigmoid(ga) * (ym @ w_bm) + jax.nn.sigmoid(gb) * (yr @ w_br)
    return y @ w_out


def hier_moe(h, w_r1, b_r1, w_r2, b_r2, w_gate, w_up, w_down):
    B, S, D = h.shape
    t = h.reshape(B * S, D)
    T = t.shape[0]
    lg1 = (t @ w_r1).astype(jnp.float32) + b_r1
    p1 = jax.nn.softmax(lg1, axis=-1)
    _, g_top = lax.top_k(lg1, 1)
    p_g = jnp.take_along_axis(p1, g_top, axis=-1)
    lg2 = ((t @ w_r2).astype(jnp.float32) + b_r2).reshape(T, N_GROUPS, EXPERTS_PER_GROUP)
    lg2_sel = jnp.take_along_axis(lg2, g_top[:, :, None], axis=1)[:, 0]
    top_v, top_i = lax.top_k(lg2_sel, TOP_K)
    w2 = jax.nn.softmax(top_v, axis=-1) * p_g
    expert_id = g_top * EXPERTS_PER_GROUP + top_i
    gates = jnp.sum(jax.nn.one_hot(expert_id, N_EXPERTS, dtype=jnp.float32) * w2[..., None], axis=1)
    out = jnp.zeros((T, D), jnp.float32)
    for e in range(N_EXPERTS):
        he = jax.nn.silu(t @ w_gate[e]) * (t @ w_up[e])
        out = out + gates[:, e:e + 1] * (he @ w_down[e]).astype(jnp.float32)
    return out.astype(h.dtype).reshape(B, S, D)


def setup_inputs(seed: int = 0) -> dict:
    key = jax.random.key(seed)
    ks = jax.random.split(key, 26)
    f32 = jnp.float32

    def nrm(k, shape, scale):
        return jax.random.normal(k, shape, f32) * scale

    x = nrm(ks[0], (BATCH, SEQ, D_MODEL), 1.0)
    c = nrm(ks[1], (BATCH, D_MODEL), 1.0)
    positions = (jax.random.randint(ks[2], (BATCH, 1), 0, MAX_POS_OFFSET, dtype=jnp.int32)
                 + jnp.arange(SEQ, dtype=jnp.int32)[None, :])
    w_ada = nrm(ks[3], (DEPTH, D_MODEL, 6 * D_MODEL), 0.5 * D_MODEL ** -0.5)
    b_ada = nrm(ks[4], (DEPTH, 6 * D_MODEL), 0.02)
    norm1_g = 1.0 + nrm(ks[5], (DEPTH, D_MODEL), 0.1)
    w_in = nrm(ks[6], (DEPTH, D_MODEL, D_IN), D_MODEL ** -0.5)
    conv_w = nrm(ks[7], (DEPTH, CONV_K, 2 * M_QK_W), CONV_K ** -0.5)
    conv_b = nrm(ks[8], (DEPTH, 2 * M_QK_W), 0.02)
    m_ig_b = nrm(ks[9], (DEPTH, M_HEADS), 0.1)
    m_fg_b = jnp.linspace(3.0, 6.0, M_HEADS, dtype=f32)[None, :] + nrm(ks[10], (DEPTH, M_HEADS), 0.1)
    m_norm_g = 1.0 + nrm(ks[11], (DEPTH, M_HEADS, M_DV), 0.1)
    r_norm_g = 1.0 + nrm(ks[12], (DEPTH, R_HEADS, R_DV), 0.1)
    w_bm = nrm(ks[13], (DEPTH, M_V_W, D_MODEL), M_V_W ** -0.5)
    w_br = nrm(ks[14], (DEPTH, R_V_W, D_MODEL), R_V_W ** -0.5)
    w_out = nrm(ks[15], (DEPTH, D_MODEL, D_MODEL), D_MODEL ** -0.5)
    norm2_g = 1.0 + nrm(ks[16], (DEPTH, D_MODEL), 0.1)
    w_r1 = nrm(ks[17], (DEPTH, D_MODEL, N_GROUPS), D_MODEL ** -0.5)
    b_r1 = nrm(ks[18], (DEPTH, N_GROUPS), 0.01)
    w_r2 = nrm(ks[19], (DEPTH, D_MODEL, N_EXPERTS), D_MODEL ** -0.5)
    b_r2 = nrm(ks[20], (DEPTH, N_EXPERTS), 0.01)
    w_gate = nrm(ks[21], (DEPTH, N_EXPERTS, D_MODEL, D_FF_EXPERT), D_MODEL ** -0.5)
    w_up = nrm(ks[22], (DEPTH, N_EXPERTS, D_MODEL, D_FF_EXPERT), D_MODEL ** -0.5)
    w_down = nrm(ks[23], (DEPTH, N_EXPERTS, D_FF_EXPERT, D_MODEL), D_FF_EXPERT ** -0.5)
    final_g = 1.0 + nrm(ks[24], (D_MODEL,), 0.1)
    return {'x': x, 'c': c, 'positions': positions, 'w_ada': w_ada, 'b_ada': b_ada, 'norm1_g': norm1_g,
            'w_in': w_in, 'conv_w': conv_w, 'conv_b': conv_b, 'm_ig_b': m_ig_b, 'm_fg_b': m_fg_b,
            'm_norm_g': m_norm_g, 'r_norm_g': r_norm_g, 'w_bm': w_bm, 'w_br': w_br, 'w_out': w_out,
            'norm2_g': norm2_g, 'w_r1': w_r1, 'b_r1': b_r1, 'w_r2': w_r2, 'b_r2': b_r2,
            'w_gate': w_gate, 'w_up': w_up, 'w_down': w_down, 'final_g': final_g}


def reference(x, c, positions, w_ada, b_ada, norm1_g, w_in, conv_w, conv_b, m_ig_b, m_fg_b, m_norm_g,
              r_norm_g, w_bm, w_br, w_out, norm2_g, w_r1, b_r1, w_r2, b_r2, w_gate, w_up, w_down, final_g):
    for l in range(DEPTH):
        mod = jax.nn.silu(c) @ w_ada[l] + b_ada[l]
        sh1, sc1, g1, sh2, sc2, g2 = jnp.split(mod[:, None, :], 6, axis=-1)
        h = rms_norm(x, norm1_g[l]) * (1.0 + sc1) + sh1
        x = x + g1 * hybrid_mixer(h, positions, w_in[l], conv_w[l], conv_b[l], m_ig_b[l], m_fg_b[l],
                                  m_norm_g[l], r_norm_g[l], w_bm[l], w_br[l], w_out[l])
        h = rms_norm(x, norm2_g[l]) * (1.0 + sc2) + sh2
        x = x + g2 * hier_moe(h, w_r1[l], b_r1[l], w_r2[l], b_r2[l], w_gate[l], w_up[l], w_down[l])
    return rms_norm(x, final_g)
```

```cpp
#include <hip/hip_runtime.h>
#include <cstdio>
#include <cstdint>

#ifndef MK_N_LAUNCHES
#define MK_N_LAUNCHES 1
#endif
#ifndef DBG_NO_MOE
#define DBG_NO_MOE 0
#endif
#ifndef DBG_SKIP_MIXER
#define DBG_SKIP_MIXER 0
#endif
#ifndef DBG_NO_MIX
#define DBG_NO_MIX 0
#endif

#define LAS __attribute__((address_space(3)))
#define GAS __attribute__((address_space(1)))
typedef unsigned short bf16_t;
typedef short bf16x8 __attribute__((ext_vector_type(8)));
typedef short s16x4 __attribute__((ext_vector_type(4)));
typedef float f32x4 __attribute__((ext_vector_type(4)));
typedef float f32x2 __attribute__((ext_vector_type(2)));
typedef unsigned u32x4 __attribute__((ext_vector_type(4)));
typedef unsigned u32x2 __attribute__((ext_vector_type(2)));
#define DI __device__ __forceinline__

constexpr int NB = 8, SEQ = 2048, D = 1024, T = NB * SEQ, DIN = 8200, NEXP = 16, DFF = 512;
constexpr float EPS = 1e-6f;
constexpr int NWAVES = 8, NTHR = 512;

constexpr size_t MiB = 1u << 20;
constexpr size_t WS_CTL = 0, CTL_ZERO_BYTES = 1 * MiB;
constexpr size_t WS_MOD = 1 * MiB;
constexpr size_t WS_GATES = 2 * MiB;
constexpr size_t WS_WTS = 3 * MiB;
constexpr size_t WS_LIST = 4 * MiB;
constexpr size_t WS_ROPE = 5 * MiB;
constexpr size_t WS_WT = 16 * MiB;
constexpr size_t WT_IN = WS_WT, WT_BM = WS_WT + 16 * MiB, WT_BR = WS_WT + 18 * MiB, WT_OUT = WS_WT + 20 * MiB, WT_GU = WS_WT + 22 * MiB, WT_DN = WS_WT + 54 * MiB;
constexpr size_t WS_H = 86 * MiB;
constexpr size_t WS_PROJ = 118 * MiB;
constexpr size_t PBLK = 32 * MiB;
constexpr int PH_MQK = 0, PH_RQK = 1, PH_MV = 2, PH_RV = 3, PH_MO = 4, PH_RG = 5, PH_GA = 6, PH_GB = 7;
constexpr size_t WS_T1 = WS_PROJ;
constexpr size_t WS_HS = WS_PROJ;
constexpr size_t WS_HE = WS_PROJ + 3 * PBLK;
constexpr size_t WS_O2 = WS_PROJ + 5 * PBLK;
constexpr size_t WS_Y = WS_PROJ + 4 * PBLK;
constexpr size_t WS_END = WS_PROJ + 8 * PBLK;
constexpr int CW_CNT = 256;
constexpr int CW_BAR = 4096;

constexpr int LDS_BYTES = 163840;
constexpr int MISC_OFF = LDS_BYTES - 256;

typedef __bf16 bf16x2_t __attribute__((ext_vector_type(2)));
DI unsigned cvt_pk_bf16(float lo, float hi) { bf16x2_t v; v[0] = (__bf16)lo; v[1] = (__bf16)hi; return __builtin_bit_cast(unsigned, v); }
DI float bf_lo(unsigned u) { return __uint_as_float(u << 16); }
DI float bf_hi(unsigned u) { return __uint_as_float(u & 0xffff0000u); }
DI float bf2f(short s) { return __uint_as_float(((unsigned)(unsigned short)s) << 16); }
DI float sigmoidf_(float x) { return __builtin_amdgcn_rcpf(1.f + __builtin_amdgcn_exp2f(-1.44269504f * x)); }
DI float siluf_(float x) { return x * sigmoidf_(x); }
DI float expf_(float x) { return __builtin_amdgcn_exp2f(1.44269504f * x); }
DI float wave_sum(float v) {
#pragma unroll
    for (int o = 1; o < 64; o <<= 1) v += __shfl_xor(v, o);
    return v;
}
DI float wave_max(float v) {
#pragma unroll
    for (int o = 1; o < 64; o <<= 1) v = fmaxf(v, __shfl_xor(v, o));
    return v;
}
#define LDS_WAIT() asm volatile("s_waitcnt lgkmcnt(0)" ::: "memory")
#define VM_WAIT() asm volatile("s_waitcnt vmcnt(0)" ::: "memory")
#define RLX_AGENT __ATOMIC_RELAXED, __HIP_MEMORY_SCOPE_AGENT

namespace pg8 {
constexpr int BM = 256, BK = 64, HALF = 128, HTB = HALF * BK * 2, STAGE_BYTES = 8 * HTB, NXCD = 8, WGM = 8;
__host__ __device__ __forceinline__ int lds_byte(int r, int c) { const int st = (r >> 4) * 2 + (c >> 5), rr = r & 15, cc = c & 31, ob = rr * 64 + cc * 2; return st * 1024 + (ob ^ (((ob >> 9) & 1) << 5)); }
__host__ __device__ __forceinline__ void stage_rc(int b, int& R, int& C) { const int st = b / 1024, sb = b % 1024, swz = sb ^ (((sb >> 9) & 1) << 5); R = (st >> 1) * 16 + swz / 64; C = (st & 1) * 32 + (swz % 64) / 2; }
__host__ __device__ __forceinline__ int perm32(int rho) { const int n = rho >> 4, i = rho & 15; return 8 * (i >> 2) + 4 * n + (i & 3); }

struct Unit { int pm, pn; const bf16_t* A; const bf16_t* Bt; int x0, x1, x2; };

template <int nM, int nN, int G>
DI bool static_tile(int i, int c, int& pm, int& pn) {
    constexpr int nwg = nM * nN; const int L = i * G + c; if (L >= nwg) return false;
    int wgid = L; { constexpr int q = nwg / NXCD, r = nwg % NXCD; const int xcd = wgid % NXCD, off = wgid / NXCD; wgid = (xcd < r ? xcd * (q + 1) : r * (q + 1) + (xcd - r) * q) + off; }
    constexpr int nig = WGM * nN; const int gid = wgid / nig, fm = gid * WGM, gsz = (nM - fm) < WGM ? (nM - fm) : WGM;
    static_assert(nM % WGM == 0, "row tiles in groups of 8");
    pm = fm + ((wgid % nig) % WGM); pn = (wgid % nig) / WGM; (void)gsz; return true;
}

template <class Epi, class Sched, bool ALIGN_EPI, bool SP2>
DI void gemm_phase(LAS unsigned char* lds, const int tid, const int K, const Sched& S, const Epi& E) {
    const int wid = __builtin_amdgcn_readfirstlane(tid >> 6), lane = tid & 63, wr = wid >> 2, wc = wid & 3, fr = lane & 15, fq = lane >> 4;
    const int nt = K / BK;
    unsigned voffA[2], voffB[2];
    unsigned opq; asm volatile("v_mov_b32 %0, 0" : "=v"(opq));
#pragma unroll
    for (int i = 0; i < 2; ++i) { int R, C; stage_rc(tid * 16 + i * 8192, R, C); const int Rb = Epi::PERM ? ((R & ~31) + perm32(R & 31)) : R;
        voffA[i] = (unsigned)(R * K + C) * 2u + opq; voffB[i] = (unsigned)(Rb * K + C) * 2u + opq; }
    const size_t kstep = (size_t)(BK * 2);
    const size_t hstep = (size_t)HALF * K * 2;
    const size_t tstep = 2 * hstep;
    const unsigned ldsw = (unsigned)wid * 1024u;
    const int aoff = lds_byte(wr * 64 + fr, fq * 8), boff = lds_byte(wc * 32 + fr, fq * 8);
#define PG8_SA(b, h) (((b) * 2 + (h)) * HTB)
#define PG8_SB(b, h) ((4 + (b) * 2 + (h)) * HTB)
#define PG8_STAGE(bufoff, gbase, voff) do { _Pragma("unroll") for (int _i = 0; _i < 2; ++_i) \
        __builtin_amdgcn_global_load_lds((const unsigned*)((const char*)(gbase) + (voff)[_i]), (LAS unsigned*)(lds + (bufoff) + ldsw + _i * 8192), 16, 0, 0); } while (0)
#define PG8_LDA(dst, b, h) do { _Pragma("unroll") for (int m = 0; m < 4; ++m) _Pragma("unroll") for (int k = 0; k < 2; ++k) dst[m][k] = *(const LAS bf16x8*)(lds + PG8_SA(b, h) + aoff + m * 2048 + k * 1024); } while (0)
#define PG8_LDB(dst, b, h) do { _Pragma("unroll") for (int n = 0; n < 2; ++n) _Pragma("unroll") for (int k = 0; k < 2; ++k) dst[n][k] = *(const LAS bf16x8*)(lds + PG8_SB(b, h) + boff + n * 2048 + k * 1024); } while (0)
#define PG8_MMA(ai, bj, At, Bt) do { __builtin_amdgcn_s_setprio(1); _Pragma("unroll") for (int m = 0; m < 4; ++m) _Pragma("unroll") for (int n = 0; n < 2; ++n) _Pragma("unroll") for (int k = 0; k < 2; ++k) \
        acc[ai][bj][m][n] = __builtin_amdgcn_mfma_f32_16x16x32_bf16(Bt[n][k], At[m][k], acc[ai][bj][m][n], 0, 0, 0); __builtin_amdgcn_s_setprio(0); } while (0)
#define PG8_WAIT_V(n) asm volatile("s_waitcnt vmcnt(" #n ")" ::: "memory")
#define PG8_WAIT_L(n) asm volatile("s_waitcnt lgkmcnt(" #n ")" ::: "memory")
#define PG8_BAR __builtin_amdgcn_s_barrier()
#define PG8_SCHED __builtin_amdgcn_sched_barrier(0)
    Unit cur, nxt; int ui = 0;
    if (!S.next(0, cur)) return;
    f32x4 acc[2][2][4][2];
#pragma unroll
    for (int a = 0; a < 2; ++a)
#pragma unroll
        for (int b = 0; b < 2; ++b)
#pragma unroll
            for (int m = 0; m < 4; ++m)
#pragma unroll
                for (int n = 0; n < 2; ++n) acc[a][b][m][n] = (f32x4){0.f, 0.f, 0.f, 0.f};
    bf16x8 At[4][2], B0[2][2], B1[2][2];
    const char* cA = (const char*)cur.A + (size_t)cur.pm * tstep; const char* cB = (const char*)cur.Bt + (size_t)cur.pn * tstep;
    if constexpr (SP2) {
        PG8_STAGE(PG8_SB(0, 0), cB, voffB); PG8_STAGE(PG8_SB(0, 1), cB + hstep, voffB); PG8_STAGE(PG8_SA(0, 0), cA, voffA); PG8_STAGE(PG8_SA(0, 1), cA + hstep, voffA);
        if (wr == 1) PG8_BAR;
        PG8_WAIT_V(2); PG8_BAR;
        PG8_STAGE(PG8_SB(1, 0), cB + kstep, voffB); PG8_STAGE(PG8_SA(1, 0), cA + kstep, voffA); PG8_STAGE(PG8_SB(1, 1), cB + hstep + kstep, voffB);
        PG8_WAIT_V(6); PG8_BAR;
    } else {
        PG8_STAGE(PG8_SB(0, 0), cB, voffB); PG8_STAGE(PG8_SA(0, 0), cA, voffA); PG8_STAGE(PG8_SB(0, 1), cB + hstep, voffB); PG8_STAGE(PG8_SA(0, 1), cA + hstep, voffA);
        if (wr == 1) PG8_BAR;
        PG8_WAIT_V(4); PG8_BAR;
        PG8_STAGE(PG8_SB(1, 0), cB + kstep, voffB); PG8_STAGE(PG8_SA(1, 0), cA + kstep, voffA); PG8_STAGE(PG8_SB(1, 1), cB + hstep + kstep, voffB);
        PG8_WAIT_V(6); PG8_BAR;
    }
    for (;;) {
        const bool has_next = S.next(ui + 1, nxt);
        const char* nA = has_next ? (const char*)nxt.A + (size_t)nxt.pm * tstep : cA; const char* nB = has_next ? (const char*)nxt.Bt + (size_t)nxt.pn * tstep : cB;
        for (int t = 0; t < nt; t += 2) {
            const bool last = (t == nt - 2);
            const char* a1 = cA + (size_t)(t + 1) * kstep;
            const char* a2 = last ? nA : cA + (size_t)(t + 2) * kstep; const char* b2 = last ? nB : cB + (size_t)(t + 2) * kstep;
            const char* a3 = a2 + kstep; const char* b3 = b2 + kstep;
            if constexpr (SP2) {
            PG8_LDB(B0, 0, 0); PG8_LDB(B1, 0, 1); PG8_SCHED; PG8_LDA(At, 0, 0); PG8_STAGE(PG8_SA(1, 1), a1 + hstep, voffA);
            PG8_WAIT_V(8); PG8_WAIT_L(0); PG8_BAR; PG8_MMA(0, 0, At, B0); PG8_MMA(0, 1, At, B1); PG8_BAR; PG8_SCHED;
            PG8_LDA(At, 0, 1); PG8_STAGE(PG8_SB(0, 0), b2, voffB); PG8_STAGE(PG8_SB(0, 1), b2 + hstep, voffB); PG8_STAGE(PG8_SA(0, 0), a2, voffA);
            PG8_WAIT_V(8); PG8_WAIT_L(0); PG8_BAR; PG8_MMA(1, 0, At, B0); PG8_MMA(1, 1, At, B1); PG8_BAR; PG8_SCHED;
            PG8_LDB(B0, 1, 0); PG8_LDB(B1, 1, 1); PG8_SCHED; PG8_LDA(At, 1, 0); PG8_STAGE(PG8_SA(0, 1), a2 + hstep, voffA);
            PG8_WAIT_V(8); PG8_WAIT_L(0); PG8_BAR; PG8_MMA(0, 0, At, B0); PG8_MMA(0, 1, At, B1); PG8_BAR; PG8_SCHED;
            PG8_LDA(At, 1, 1); PG8_STAGE(PG8_SB(1, 0), b3, voffB); PG8_STAGE(PG8_SB(1, 1), b3 + hstep, voffB); PG8_STAGE(PG8_SA(1, 0), a3, voffA);
            PG8_WAIT_V(8); PG8_WAIT_L(0); PG8_BAR; PG8_MMA(1, 0, At, B0); PG8_MMA(1, 1, At, B1); PG8_BAR; PG8_SCHED;
            } else {
            PG8_LDB(B0, 0, 0); PG8_SCHED; PG8_LDA(At, 0, 0); PG8_STAGE(PG8_SA(1, 1), a1 + hstep, voffA);
            PG8_WAIT_L(8); PG8_BAR; PG8_WAIT_L(0); PG8_MMA(0, 0, At, B0); PG8_BAR; PG8_SCHED;
            PG8_LDB(B1, 0, 1); PG8_STAGE(PG8_SB(0, 0), b2, voffB);
            PG8_BAR; PG8_WAIT_L(0); PG8_MMA(0, 1, At, B1); PG8_BAR;
            PG8_LDA(At, 0, 1); PG8_STAGE(PG8_SA(0, 0), a2, voffA);
            PG8_BAR; PG8_WAIT_L(0); PG8_MMA(1, 0, At, B0); PG8_BAR; PG8_SCHED;
            PG8_STAGE(PG8_SB(0, 1), b2 + hstep, voffB);
            PG8_WAIT_V(6); PG8_BAR; PG8_MMA(1, 1, At, B1); PG8_BAR;
            PG8_LDB(B0, 1, 0); PG8_SCHED; PG8_LDA(At, 1, 0); PG8_STAGE(PG8_SA(0, 1), a2 + hstep, voffA);
            PG8_WAIT_L(8); PG8_BAR; PG8_WAIT_L(0); PG8_MMA(0, 0, At, B0); PG8_BAR; PG8_SCHED;
            PG8_LDB(B1, 1, 1); PG8_STAGE(PG8_SB(1, 0), b3, voffB);
            PG8_BAR; PG8_WAIT_L(0); PG8_MMA(0, 1, At, B1); PG8_BAR;
            PG8_LDA(At, 1, 1); PG8_STAGE(PG8_SA(1, 0), a3, voffA);
            PG8_BAR; PG8_WAIT_L(0); PG8_MMA(1, 0, At, B0); PG8_BAR; PG8_SCHED;
            PG8_STAGE(PG8_SB(1, 1), b3 + hstep, voffB);
            PG8_WAIT_V(6); PG8_BAR; PG8_MMA(1, 1, At, B1); PG8_BAR;
            }
        }
        if constexpr (ALIGN_EPI) { if (wr == 0) PG8_BAR; }
        E(acc, cur, wr, wc, fr, fq);
        if (!has_next) break;
#pragma unroll
        for (int a = 0; a < 2; ++a)
#pragma unroll
            for (int b = 0; b < 2; ++b)
#pragma unroll
                for (int m = 0; m < 4; ++m)
#pragma unroll
                    for (int n = 0; n < 2; ++n) acc[a][b][m][n] = (f32x4){0.f, 0.f, 0.f, 0.f};
        cur = nxt; cA = nA; cB = nB; ++ui;
        if constexpr (ALIGN_EPI) { if (wr == 1) PG8_BAR; }
    }
    PG8_WAIT_V(0);
    if constexpr (!ALIGN_EPI) { if (wr == 0) PG8_BAR; }
    PG8_BAR;
#undef PG8_SA
#undef PG8_SB
#undef PG8_STAGE
#undef PG8_LDA
#undef PG8_LDB
#undef PG8_MMA
#undef PG8_WAIT_V
#undef PG8_WAIT_L
#undef PG8_BAR
#undef PG8_SCHED
}
}

typedef f32x4 AccT[2][2][4][2];
using pg8::Unit;


struct EpiG1 {
    static constexpr bool PERM = true;
    bf16_t* proj;
    DI void operator()(const AccT& acc, const Unit& u, int wr, int wc, int fr, int fq) const {
        const int lb = u.pn >> 2;
        const int phys = lb == 0 ? PH_MQK : lb == 1 ? PH_MV : lb == 2 ? PH_MO : lb == 3 ? PH_RQK : lb == 4 ? PH_RV : lb == 5 ? PH_RG : lb == 6 ? PH_GA : PH_GB;
        const int act = (lb == 2 || lb == 6 || lb == 7) ? 1 : (lb == 5 ? 2 : 0);
        bf16_t* base = proj + (size_t)phys * ((size_t)T * 1024);
        const int row0 = u.pm * 256 + wr * 64 + fr, col0 = (u.pn & 3) * 256 + wc * 32 + 8 * fq;
#pragma unroll
        for (int ai = 0; ai < 2; ++ai)
#pragma unroll
            for (int m = 0; m < 4; ++m) { bf16_t* rowp = base + (size_t)(row0 + ai * 128 + m * 16) * 1024 + col0;
#pragma unroll
                for (int bj = 0; bj < 2; ++bj) { f32x4 v0 = acc[ai][bj][m][0], v1 = acc[ai][bj][m][1];
                    if (act == 1) {
#pragma unroll
                        for (int i = 0; i < 4; ++i) { v0[i] = sigmoidf_(v0[i]); v1[i] = sigmoidf_(v1[i]); }
                    } else if (act == 2) {
#pragma unroll
                        for (int i = 0; i < 4; ++i) { v0[i] = siluf_(v0[i]); v1[i] = siluf_(v1[i]); }
                    }
                    u32x4 w; w.x = cvt_pk_bf16(v0[0], v0[1]); w.y = cvt_pk_bf16(v0[2], v0[3]); w.z = cvt_pk_bf16(v1[0], v1[1]); w.w = cvt_pk_bf16(v1[2], v1[3]);
                    *(u32x4*)(rowp + bj * 128) = w; }
                asm volatile("" ::: "memory"); }
    }
};
struct EpiBr {
    static constexpr bool PERM = true;
    const bf16_t* ga; const bf16_t* gb; float* t1; bf16_t* y;
    DI void operator()(const AccT& acc, const Unit& u, int wr, int wc, int fr, int fq) const {
        const int row0 = u.pm * 256 + wr * 64 + fr, col0 = u.pn * 256 + wc * 32 + 8 * fq;
        const bf16_t* g = u.x0 ? gb : ga;
#pragma unroll
        for (int ai = 0; ai < 2; ++ai)
#pragma unroll
            for (int m = 0; m < 4; ++m) { const size_t off = (size_t)(row0 + ai * 128 + m * 16) * 1024 + col0;
#pragma unroll
                for (int bj = 0; bj < 2; ++bj) { const u32x4 gw = *(const u32x4*)(g + off + bj * 128);
                    f32x4 v0 = acc[ai][bj][m][0], v1 = acc[ai][bj][m][1];
                    v0[0] *= bf_lo(gw.x); v0[1] *= bf_hi(gw.x); v0[2] *= bf_lo(gw.y); v0[3] *= bf_hi(gw.y);
                    v1[0] *= bf_lo(gw.z); v1[1] *= bf_hi(gw.z); v1[2] *= bf_lo(gw.w); v1[3] *= bf_hi(gw.w);
                    if (u.x0 == 0) { *(f32x4*)(t1 + off + bj * 128) = v0; *(f32x4*)(t1 + off + bj * 128 + 4) = v1; }
                    else { const f32x4 p0 = *(const f32x4*)(t1 + off + bj * 128), p1 = *(const f32x4*)(t1 + off + bj * 128 + 4); v0 += p0; v1 += p1;
                        u32x4 w; w.x = cvt_pk_bf16(v0[0], v0[1]); w.y = cvt_pk_bf16(v0[2], v0[3]); w.z = cvt_pk_bf16(v1[0], v1[1]); w.w = cvt_pk_bf16(v1[2], v1[3]);
                        *(u32x4*)(y + off + bj * 128) = w; } }
                asm volatile("" ::: "memory"); }
    }
};
struct EpiOut {
    static constexpr bool PERM = false;
    const float* base; float* out; const float* g1;
    DI void operator()(const AccT& acc, const Unit& u, int wr, int wc, int fr, int fq) const {
        const int row0 = u.pm * 256 + wr * 64 + fr, col0 = u.pn * 256 + wc * 32 + 4 * fq;
        const float* gp = g1 + (size_t)(u.pm >> 3) * 6144 + 2048 + col0;
        f32x4 gv[2][2];
#pragma unroll
        for (int bj = 0; bj < 2; ++bj)
#pragma unroll
            for (int n = 0; n < 2; ++n) gv[bj][n] = *(const f32x4*)(gp + bj * 128 + n * 16);
#pragma unroll
        for (int ai = 0; ai < 2; ++ai)
#pragma unroll
            for (int m = 0; m < 4; ++m) { const size_t off = (size_t)(row0 + ai * 128 + m * 16) * 1024 + col0;
#pragma unroll
                for (int bj = 0; bj < 2; ++bj)
#pragma unroll
                    for (int n = 0; n < 2; ++n) { const f32x4 bs = *(const f32x4*)(base + off + bj * 128 + n * 16);
                        *(f32x4*)(out + off + bj * 128 + n * 16) = DBG_NO_MIX ? bs : bs + gv[bj][n] * acc[ai][bj][m][n]; }
                asm volatile("" ::: "memory"); }
    }
};
struct EpiGU {
    static constexpr bool PERM = false;
    bf16_t* he;
    DI void operator()(const AccT& acc, const Unit& u, int wr, int wc, int fr, int fq) const {
        const int row0 = u.pm * 256 + wr * 64 + fr;
#pragma unroll
        for (int ai = 0; ai < 2; ++ai)
#pragma unroll
            for (int m = 0; m < 4; ++m) { bf16_t* rowp = he + (size_t)(row0 + ai * 128 + m * 16) * DFF;
#pragma unroll
                for (int bj = 0; bj < 2; ++bj) { const int ff0 = 16 * (8 * u.pn + 4 * bj + wc) + 4 * fq;
                    const f32x4 g = acc[ai][bj][m][0], up = acc[ai][bj][m][1];
                    u32x2 w; w.x = cvt_pk_bf16(siluf_(g[0]) * up[0], siluf_(g[1]) * up[1]); w.y = cvt_pk_bf16(siluf_(g[2]) * up[2], siluf_(g[3]) * up[3]);
                    *(u32x2*)(rowp + ff0) = w; } }
    }
};
struct EpiDN {
    static constexpr bool PERM = true;
    const int* list; const float* wts; bf16_t* o2;
    DI void operator()(const AccT& acc, const Unit& u, int wr, int wc, int fr, int fq) const {
        const int p0 = u.x1 * 256 + wr * 64 + fr, col0 = u.pn * 256 + wc * 32 + 8 * fq;
#pragma unroll
        for (int ai = 0; ai < 2; ++ai)
#pragma unroll
            for (int m = 0; m < 4; ++m) { const int p = p0 + ai * 128 + m * 16;
                if (p < u.x2) { const int id = list[(size_t)u.x0 * T + p]; const float s = wts[id]; bf16_t* rowp = o2 + (size_t)id * 1024 + col0;
#pragma unroll
                    for (int bj = 0; bj < 2; ++bj) { const f32x4 v0 = acc[ai][bj][m][0] * s, v1 = acc[ai][bj][m][1] * s;
                        u32x4 ww; ww.x = cvt_pk_bf16(v0[0], v0[1]); ww.y = cvt_pk_bf16(v0[2], v0[3]); ww.z = cvt_pk_bf16(v1[0], v1[1]); ww.w = cvt_pk_bf16(v1[2], v1[3]);
                        *(u32x4*)(rowp + bj * 128) = ww; } }
                asm volatile("" ::: "memory"); }
    }
};

constexpr int GRID = 256;
template <int nN>
struct DenseOrder {
    const bf16_t* A; const bf16_t* Bt; int c;
    DI bool next(int i, Unit& u) const { int pm, pn; if (!pg8::static_tile<T / 256, nN, GRID>(i, c, pm, pn)) return false; u.pm = pm; u.pn = pn; u.A = A; u.Bt = Bt; u.x0 = 0; u.x1 = 0; u.x2 = 0; return true; }
};
struct BranchOrder {
    const bf16_t* A0; const bf16_t* A1; const bf16_t* B0; const bf16_t* B1; int c;
    DI bool next(int i, Unit& u) const { int pm, pn; if (!pg8::static_tile<T / 256, D / 256, GRID>(i >> 1, c, pm, pn)) return false;
        u.pm = pm; u.pn = pn; u.x0 = i & 1; u.A = (i & 1) ? A1 : A0; u.Bt = (i & 1) ? B1 : B0; u.x1 = 0; u.x2 = 0; return true; }
};
struct MoeOrder {
    const bf16_t* A; const bf16_t* Bt; size_t bstride; const unsigned* cnt; int c;
    DI bool next(int i, Unit& u) const {
        const int idx = i * GRID + c, rt = idx >> 2; int acc = 0, e = -1, jt = 0, ce = 0;
#pragma unroll
        for (int k = 0; k < NEXP; ++k) { const int n = (int)__builtin_amdgcn_readfirstlane(__hip_atomic_load(cnt + k, RLX_AGENT)); const int ntile = (n + 255) >> 8;
            if (e < 0 && rt < acc + ntile) { e = k; jt = rt - acc; ce = n; } acc += ntile; }
        if (e < 0) return false;
        u.pm = rt; u.pn = idx & 3; u.A = A; u.Bt = Bt + (size_t)e * bstride; u.x0 = e; u.x1 = jt; u.x2 = ce; return true;
    }
};

#define XB_TMO      128
#define XB_XCNT(j)  (256  + 64 * (j))
#define XB_XSUB(j)  (1280 + 64 * (j))
#define XB_XGEN(j)  (2304 + 64 * (j))
#define XB_TOP      3328
#define XB_TOPGEN   3392
#define XCD_BAR_WORDS 3456
#define XB_SPIN_CAP (1u << 22)
DI unsigned xb_ld(unsigned* p)              { return __hip_atomic_load(p, __ATOMIC_RELAXED, __HIP_MEMORY_SCOPE_AGENT); }
DI unsigned xb_add(unsigned* p, unsigned v) { return __hip_atomic_fetch_add(p, v, __ATOMIC_RELAXED, __HIP_MEMORY_SCOPE_AGENT); }
DI unsigned xb_xcc_id() { return (unsigned)__builtin_amdgcn_s_getreg((3 << 11) | 20) & 0xFu; }
#define XB_SPIN(cond, bar) do { unsigned _sp = 0; while (cond) { __builtin_amdgcn_s_sleep(1); \
    if ((++_sp & 255u) == 0u) { if (xb_ld(&(bar)[XB_TMO])) break; if (_sp > XB_SPIN_CAP) { atomicAdd(&(bar)[XB_TMO], 1u); break; } } } } while (0)
struct XcdBarrier { unsigned* bar; unsigned x; volatile LAS unsigned* st; };
DI XcdBarrier xcd_barrier_post(unsigned* bar, volatile LAS unsigned* st) {
    XcdBarrier b; b.bar = bar; b.x = xb_xcc_id(); b.st = st;
    if (threadIdx.x == 0) (void)xb_add(&bar[XB_XCNT(b.x)], 1u);
    return b;
}
DI void xcd_barrier_complete(unsigned* bar, unsigned x, unsigned& nloc, unsigned& nx) {
    const unsigned G = gridDim.x * gridDim.y * gridDim.z;
    unsigned sum, cnt, mine, sp = 0u;
    for (;;) {
        sum = 0u; cnt = 0u; mine = 0u;
#pragma unroll
        for (unsigned j = 0; j < 16; ++j) { const unsigned c = xb_ld(&bar[XB_XCNT(j)]); sum += c; cnt += (c > 0u) ? 1u : 0u; mine = (j == x) ? c : mine; }
        if (sum == G) break;
        __builtin_amdgcn_s_sleep(1);
        if ((++sp & 255u) == 0u) { if (xb_ld(&bar[XB_TMO])) break; if (sp > XB_SPIN_CAP) { atomicAdd(&bar[XB_TMO], 1u); break; } }
    }
    nloc = mine > 0u ? mine : 1u; nx = cnt > 0u ? cnt : 1u;
}
DI void xcd_barrier(const XcdBarrier& b) {
    asm volatile("s_waitcnt vmcnt(0)" ::: "memory");
    __syncthreads();
    if (threadIdx.x == 0) {
        unsigned* bar = b.bar;
        __builtin_amdgcn_s_waitcnt(0);
        unsigned nloc = b.st[0], nx = b.st[1];
        if (nloc == 0u) { xcd_barrier_complete(bar, b.x, nloc, nx); b.st[0] = nloc; b.st[1] = nx; }
        const unsigned old = xb_add(&bar[XB_XSUB(b.x)], 1u);
        const unsigned gen = old / nloc;
        if (old + 1u == (gen + 1u) * nloc) {
            __builtin_amdgcn_fence(__ATOMIC_RELEASE, "agent");
            asm volatile("s_waitcnt vmcnt(0)" ::: "memory");
            const unsigned og = xb_add(&bar[XB_TOP], 1u);
            const unsigned tg = og / nx;
            if (og + 1u == (tg + 1u) * nx) xb_add(&bar[XB_TOPGEN], 1u);
            else XB_SPIN(xb_ld(&bar[XB_TOPGEN]) == tg, bar);
            __builtin_amdgcn_fence(__ATOMIC_ACQUIRE, "agent");
            xb_add(&bar[XB_XGEN(b.x)], 1u);
            asm volatile("s_waitcnt vmcnt(0)" ::: "memory");
        } else {
            XB_SPIN(xb_ld(&bar[XB_XGEN(b.x)]) == gen, bar);
            __builtin_amdgcn_fence(__ATOMIC_ACQUIRE, "agent");
            asm volatile("s_waitcnt vmcnt(0)" ::: "memory");
        }
    }
    __syncthreads();
}

struct Frame {
    LAS unsigned char* lds;
    int tid, lane, wave, vcu, G;
    const float* const* in;
    float* out; unsigned char* ws;
};
enum { I_X = 0, I_C, I_POS, I_WADA, I_BADA, I_N1G, I_WIN, I_CONVW, I_CONVB, I_MIGB, I_MFGB, I_MNG, I_RNG, I_WBM, I_WBR, I_WOUT, I_N2G, I_WR1, I_BR1, I_WR2, I_BR2, I_WGATE, I_WUP, I_WDOWN, I_FG, N_IN };

struct Args { const float* in[N_IN]; float* out; unsigned char* ws; int ph_lo, ph_hi; };

DI void mods_phase(const Frame& F, const float* c, const float* w_ada, const float* b_ada, float* mod) {
    LAS float* sc = (LAS float*)F.lds;
    LAS float* red = (LAS float*)(F.lds + 32768);
    for (int i = F.tid; i < 8 * 1024; i += NTHR) sc[i] = siluf_(c[i]);
    __syncthreads();
    for (int it = F.vcu; it < 256; it += F.G) {
        const int l = it >> 7, cb = it & 127;
        const int c4 = F.tid % 12, ks = F.tid / 12;
        if (ks < 42) {
            f32x4 acc[8];
#pragma unroll
            for (int b = 0; b < 8; ++b) acc[b] = (f32x4){0.f, 0.f, 0.f, 0.f};
            for (int k = ks; k < 1024; k += 42) {
                const f32x4 w = *(const f32x4*)(w_ada + ((size_t)l * 1024 + k) * 6144 + 48 * cb + 4 * c4);
#pragma unroll
                for (int b = 0; b < 8; ++b) acc[b] += w * sc[b * 1024 + k];
            }
#pragma unroll
            for (int b = 0; b < 8; ++b) *(LAS f32x4*)(red + (ks * 8 + b) * 48 + 4 * c4) = acc[b];
        }
        __syncthreads();
        if (F.tid < 384) { const int b = F.tid / 48, col = F.tid % 48; float s = 0.f;
            for (int k = 0; k < 42; ++k) s += red[(k * 8 + b) * 48 + col];
            mod[((size_t)l * 8 + b) * 6144 + 48 * cb + col] = s + b_ada[l * 6144 + 48 * cb + col]; }
        __syncthreads();
    }
}
DI void rope_phase(const Frame& F, const int* pos, float* rope) {
    const int gt = F.vcu * NTHR + F.tid, NGT = F.G * NTHR;
    for (int i = gt; i < T * 64; i += NGT) {
        const int t = i >> 6, j = i & 63;
        const double inv = exp2(-(double)j * (13.287712379549449 / 64.0));
        const double ang = (double)pos[t] * inv;
        double r = ang * 0.15915494309189535; r -= rint(r);
        const double q = rint(r * 4.0); const double th = (r - q * 0.25) * 6.283185307179586; const int qi = ((int)q) & 3;
        const double t2 = th * th;
        const double s = th * (1.0 + t2 * (-1.0 / 6 + t2 * (1.0 / 120 + t2 * (-1.0 / 5040 + t2 * (1.0 / 362880 + t2 * (-1.0 / 39916800 + t2 * (1.0 / 6227020800.0)))))));
        const double cc = 1.0 + t2 * (-0.5 + t2 * (1.0 / 24 + t2 * (-1.0 / 720 + t2 * (1.0 / 40320 + t2 * (-1.0 / 3628800 + t2 * (1.0 / 479001600.0 + t2 * (-1.0 / 87178291200.0)))))));
        const double cs = qi == 0 ? cc : qi == 1 ? -s : qi == 2 ? -cc : s;
        const double sn = qi == 0 ? s : qi == 1 ? cc : qi == 2 ? -s : -cc;
        rope[(size_t)t * 128 + j] = (float)cs; rope[(size_t)t * 128 + 64 + j] = (float)sn;
    }
}
template <class Src>
DI void transpose_item(const Src& src, bf16_t* dst, int Kdst, LAS float* scr, int lane) {
#pragma unroll 8
    for (int i = 0; i < 32; ++i) { const int kk = 2 * i + (lane >> 5); scr[kk * 33 + (lane & 31)] = src(kk, lane & 31); }
    LDS_WAIT(); asm volatile("" ::: "memory");
    const int c = lane & 7;
#pragma unroll
    for (int j = 0; j < 4; ++j) { const int n = (lane >> 3) + 8 * j; const LAS float* s = scr + (8 * c) * 33 + n;
        u32x4 o; o.x = cvt_pk_bf16(s[0 * 33], s[1 * 33]); o.y = cvt_pk_bf16(s[2 * 33], s[3 * 33]); o.z = cvt_pk_bf16(s[4 * 33], s[5 * 33]); o.w = cvt_pk_bf16(s[6 * 33], s[7 * 33]);
        *(u32x4*)(dst + (size_t)n * Kdst + 8 * c) = o; }
    LDS_WAIT(); asm volatile("" ::: "memory");
}
DI void convert_weights(const Frame& F, int l) {
    LAS float* scr = (LAS float*)(F.lds + 65536 + F.wave * 8448);
    const int gw = F.vcu * NWAVES + F.wave, NGW = F.G * NWAVES, lane = F.lane;
    const float* w_in = F.in[I_WIN] + (size_t)l * 1024 * DIN;
    const float* w_bm = F.in[I_WBM] + (size_t)l * 1024 * 1024; const float* w_br = F.in[I_WBR] + (size_t)l * 1024 * 1024; const float* w_out = F.in[I_WOUT] + (size_t)l * 1024 * 1024;
    const float* mng = F.in[I_MNG] + l * 1024; const float* rng = F.in[I_RNG] + l * 1024;
    const float* w_gate = F.in[I_WGATE] + (size_t)l * NEXP * 1024 * DFF; const float* w_up = F.in[I_WUP] + (size_t)l * NEXP * 1024 * DFF; const float* w_down = F.in[I_WDOWN] + (size_t)l * NEXP * DFF * 1024;
    bf16_t* t_in = (bf16_t*)(F.ws + WT_IN); bf16_t* t_bm = (bf16_t*)(F.ws + WT_BM); bf16_t* t_br = (bf16_t*)(F.ws + WT_BR); bf16_t* t_out = (bf16_t*)(F.ws + WT_OUT);
    bf16_t* t_gu = (bf16_t*)(F.ws + WT_GU); bf16_t* t_dn = (bf16_t*)(F.ws + WT_DN);
    constexpr int I_A = 16 * 256, I_B = 16 * 32, I_C = NEXP * 16 * 32, I_D = NEXP * 8 * 32;
    constexpr int NITEMS = I_A + 3 * I_B + I_C + I_D;
    for (int it = gw; it < NITEMS; it += NGW) {
        int r = it;
        if (r < I_A) { const int kb = r >> 8, nb = r & 255, k0 = 64 * kb, n0 = 32 * nb; const int sc0 = n0 + (n0 >= 3072 ? 8 : 0);
            const float* s = w_in + (size_t)k0 * DIN + sc0;
            transpose_item([&](int kk, int n) { return s[(size_t)kk * DIN + n]; }, t_in + (size_t)n0 * 1024 + k0, 1024, scr, lane); continue; }
        r -= I_A;
        if (r < 3 * I_B) { const int which = r / I_B, q = r % I_B, kb = q >> 5, nb = q & 31, k0 = 64 * kb, n0 = 32 * nb;
            const float* W = which == 0 ? w_bm : which == 1 ? w_br : w_out; bf16_t* Dst = which == 0 ? t_bm : which == 1 ? t_br : t_out;
            const float* g = which == 0 ? mng : rng; const bool sc = which < 2;
            const float* s = W + (size_t)k0 * 1024 + n0;
            transpose_item([&](int kk, int n) { const float v = s[(size_t)kk * 1024 + n]; return sc ? v * g[k0 + kk] : v; }, Dst + (size_t)n0 * 1024 + k0, 1024, scr, lane); continue; }
        r -= 3 * I_B;
        if (r < I_C) { const int e = r >> 9, q = r & 511, kb = q >> 5, qb = q & 31, k0 = 64 * kb;
            const float* sg = w_gate + ((size_t)e * 1024 + k0) * DFF + 16 * qb; const float* su = w_up + ((size_t)e * 1024 + k0) * DFF + 16 * qb;
            transpose_item([&](int kk, int n) { return (n < 16 ? sg : su)[(size_t)kk * DFF + (n & 15)]; }, t_gu + ((size_t)e * 1024 + 32 * qb) * 1024 + k0, 1024, scr, lane); continue; }
        r -= I_C;
        { const int e = r >> 8, q = r & 255, kb = q >> 5, nb = q & 31, k0 = 64 * kb, n0 = 32 * nb;
            const float* s = w_down + ((size_t)e * DFF + k0) * 1024 + n0;
            transpose_item([&](int kk, int n) { return s[(size_t)kk * 1024 + n]; }, t_dn + ((size_t)e * 1024 + n0) * DFF + k0, DFF, scr, lane); }
    }
}

DI void rp1_phase(const Frame& F, int l) {
    LAS float* wg = (LAS float*)F.lds;
    const float* w_in = F.in[I_WIN] + (size_t)l * 1024 * DIN;
    for (int i = F.tid; i < 2048; i += NTHR) { const int k = i >> 1, hf = i & 1; *(LAS f32x4*)(wg + k * 8 + 4 * hf) = *(const f32x4*)(w_in + (size_t)k * DIN + 3072 + 4 * hf); }
    __syncthreads();
    const float* mod = (const float*)(F.ws + WS_MOD);
    const float* xin = l == 0 ? F.in[I_X] : F.out;
    const bf16_t* o2 = (const bf16_t*)(F.ws + WS_O2);
    bf16_t* H = (bf16_t*)(F.ws + WS_H); float* gates = (float*)(F.ws + WS_GATES);
    const int rows_per_wg = T / F.G, rpw = rows_per_wg / NWAVES, lane = F.lane;
    const int row0 = F.vcu * rows_per_wg + F.wave * rpw, b = row0 / SEQ;
    const float* m = mod + ((size_t)l * 8 + b) * 6144;
    f32x4 gm[4], sh[4], g2[4];
#pragma unroll
    for (int j = 0; j < 4; ++j) { const int c = 4 * lane + 256 * j; const f32x4 g = *(const f32x4*)(F.in[I_N1G] + l * 1024 + c); const f32x4 s1 = *(const f32x4*)(m + 1024 + c);
        gm[j] = g * (s1 + 1.0f); sh[j] = *(const f32x4*)(m + c);
        g2[j] = l > 0 ? *(const f32x4*)(mod + ((size_t)(l - 1) * 8 + b) * 6144 + 5 * 1024 + c) : (f32x4){0.f, 0.f, 0.f, 0.f}; }
    const float bias = lane < 4 ? F.in[I_MIGB][l * 4 + (lane & 3)] : F.in[I_MFGB][l * 4 + (lane & 3)];
    for (int i = 0; i < rpw; ++i) {
        const int row = row0 + i;
        f32x4 x[4];
#pragma unroll
        for (int j = 0; j < 4; ++j) x[j] = *(const f32x4*)(xin + (size_t)row * 1024 + 4 * lane + 256 * j);
        if (l > 0) {
#pragma unroll
            for (int j = 0; j < 4; ++j) { const u32x2 a = *(const u32x2*)(o2 + ((size_t)row * 2) * 1024 + 4 * lane + 256 * j), bb = *(const u32x2*)(o2 + ((size_t)row * 2 + 1) * 1024 + 4 * lane + 256 * j);
                f32x4 o; o[0] = bf_lo(a.x) + bf_lo(bb.x); o[1] = bf_hi(a.x) + bf_hi(bb.x); o[2] = bf_lo(a.y) + bf_lo(bb.y); o[3] = bf_hi(a.y) + bf_hi(bb.y);
                if (DBG_NO_MOE) o = o * 0.f;
                x[j] += g2[j] * o; *(f32x4*)(F.out + (size_t)row * 1024 + 4 * lane + 256 * j) = x[j]; }
        }
        float ss = 0.f;
#pragma unroll
        for (int j = 0; j < 4; ++j) ss += (x[j][0] * x[j][0] + x[j][1] * x[j][1]) + (x[j][2] * x[j][2] + x[j][3] * x[j][3]);
        const float rstd = 1.0f / sqrtf(wave_sum(ss) * (1.0f / 1024.0f) + EPS);
        float p[8];
#pragma unroll
        for (int q = 0; q < 8; ++q) p[q] = 0.f;
#pragma unroll
        for (int j = 0; j < 4; ++j) { const f32x4 hv = x[j] * rstd * gm[j] + sh[j];
            u32x2 w; w.x = cvt_pk_bf16(hv[0], hv[1]); w.y = cvt_pk_bf16(hv[2], hv[3]);
            *(u32x2*)(H + (size_t)row * 1024 + 4 * lane + 256 * j) = w;
#pragma unroll
            for (int e = 0; e < 4; ++e) { const int k = 4 * lane + 256 * j + e; const f32x4 w0 = *(const LAS f32x4*)(wg + k * 8), w1 = *(const LAS f32x4*)(wg + k * 8 + 4);
                p[0] += hv[e] * w0[0]; p[1] += hv[e] * w0[1]; p[2] += hv[e] * w0[2]; p[3] += hv[e] * w0[3];
                p[4] += hv[e] * w1[0]; p[5] += hv[e] * w1[1]; p[6] += hv[e] * w1[2]; p[7] += hv[e] * w1[3]; } }
#pragma unroll
        for (int q = 0; q < 8; ++q) p[q] = wave_sum(p[q]);
        const float mine = lane == 0 ? p[0] : lane == 1 ? p[1] : lane == 2 ? p[2] : lane == 3 ? p[3] : lane == 4 ? p[4] : lane == 5 ? p[5] : lane == 6 ? p[6] : p[7];
        if (lane < 8) gates[(size_t)row * 8 + lane] = mine + bias;
    }
}
DI void norm_phase(const Frame& F) {
    bf16_t* P = (bf16_t*)(F.ws + WS_PROJ);
    const int gw = F.vcu * NWAVES + F.wave, NGW = F.G * NWAVES, lane = F.lane;
    for (int it = gw; it < 2 * T; it += NGW) {
        const int row = it >> 1, br = it & 1;
        bf16_t* v = P + (size_t)(br ? PH_RV : PH_MV) * ((size_t)T * 1024) + (size_t)row * 1024 + 4 * lane;
        const bf16_t* g = P + (size_t)(br ? PH_RG : PH_MO) * ((size_t)T * 1024) + (size_t)row * 1024 + 4 * lane;
        u32x2 a[4], gg[4];
#pragma unroll
        for (int j = 0; j < 4; ++j) { a[j] = *(const u32x2*)(v + 256 * j); gg[j] = *(const u32x2*)(g + 256 * j); }
#pragma unroll
        for (int j = 0; j < 4; ++j) { const float x0 = bf_lo(a[j].x), x1 = bf_hi(a[j].x), x2 = bf_lo(a[j].y), x3 = bf_hi(a[j].y);
            const float ss = wave_sum((x0 * x0 + x1 * x1) + (x2 * x2 + x3 * x3));
            const float rstd = 1.0f / sqrtf(ss * (1.0f / 256.0f) + EPS);
            u32x2 w; w.x = cvt_pk_bf16(x0 * rstd * bf_lo(gg[j].x), x1 * rstd * bf_hi(gg[j].x)); w.y = cvt_pk_bf16(x2 * rstd * bf_lo(gg[j].y), x3 * rstd * bf_hi(gg[j].y));
            *(u32x2*)(v + 256 * j) = w; }
    }
}
DI void rp2_phase(const Frame& F, int l) {
    LAS float* wr = (LAS float*)F.lds;
    LAS int* ent = (LAS int*)(F.lds + 81920);
    const float* w_r1 = F.in[I_WR1] + (size_t)l * 1024 * 4; const float* w_r2 = F.in[I_WR2] + (size_t)l * 1024 * 16;
    for (int i = F.tid; i < 1024 * 5; i += NTHR) { const int k = i / 5, q = i % 5;
        const f32x4 v = q == 0 ? *(const f32x4*)(w_r1 + k * 4) : *(const f32x4*)(w_r2 + k * 16 + 4 * (q - 1));
        *(LAS f32x4*)(wr + k * 20 + 4 * q) = v; }
    __syncthreads();
    const float* mod = (const float*)(F.ws + WS_MOD);
    bf16_t* H = (bf16_t*)(F.ws + WS_H); float* wts = (float*)(F.ws + WS_WTS); int* list = (int*)(F.ws + WS_LIST);
    unsigned* gcnt = (unsigned*)(F.ws + WS_CTL) + CW_CNT + 64 * l;
    const int rows_per_wg = T / F.G, rpw = rows_per_wg / NWAVES, lane = F.lane;
    const int rbase = F.vcu * rows_per_wg, row0 = rbase + F.wave * rpw, b = row0 / SEQ;
    const float* m = mod + ((size_t)l * 8 + b) * 6144;
    f32x4 gm[4], sh[4];
#pragma unroll
    for (int j = 0; j < 4; ++j) { const int c = 4 * lane + 256 * j; const f32x4 g = *(const f32x4*)(F.in[I_N2G] + l * 1024 + c); const f32x4 s2 = *(const f32x4*)(m + 4 * 1024 + c);
        gm[j] = g * (s2 + 1.0f); sh[j] = *(const f32x4*)(m + 3 * 1024 + c); }
    float b1[4], b2[16];
#pragma unroll
    for (int q = 0; q < 4; ++q) b1[q] = F.in[I_BR1][l * 4 + q];
#pragma unroll
    for (int q = 0; q < 16; ++q) b2[q] = F.in[I_BR2][l * 16 + q];
    for (int i = 0; i < rpw; ++i) {
        const int row = row0 + i;
        f32x4 x[4];
#pragma unroll
        for (int j = 0; j < 4; ++j) x[j] = *(const f32x4*)(F.out + (size_t)row * 1024 + 4 * lane + 256 * j);
        float ss = 0.f;
#pragma unroll
        for (int j = 0; j < 4; ++j) ss += (x[j][0] * x[j][0] + x[j][1] * x[j][1]) + (x[j][2] * x[j][2] + x[j][3] * x[j][3]);
        const float rstd = 1.0f / sqrtf(wave_sum(ss) * (1.0f / 1024.0f) + EPS);
        float p[20];
#pragma unroll
        for (int q = 0; q < 20; ++q) p[q] = 0.f;
#pragma unroll
        for (int j = 0; j < 4; ++j) { const f32x4 hv = x[j] * rstd * gm[j] + sh[j];
            u32x2 w; w.x = cvt_pk_bf16(hv[0], hv[1]); w.y = cvt_pk_bf16(hv[2], hv[3]);
            *(u32x2*)(H + (size_t)row * 1024 + 4 * lane + 256 * j) = w;
#pragma unroll
            for (int e = 0; e < 4; ++e) { const int k = 4 * lane + 256 * j + e;
#pragma unroll
                for (int q = 0; q < 5; ++q) { const f32x4 wv = *(const LAS f32x4*)(wr + k * 20 + 4 * q);
                    p[4 * q] += hv[e] * wv[0]; p[4 * q + 1] += hv[e] * wv[1]; p[4 * q + 2] += hv[e] * wv[2]; p[4 * q + 3] += hv[e] * wv[3]; } } }
#pragma unroll
        for (int q = 0; q < 20; ++q) p[q] = wave_sum(p[q]);
        float l1[4];
#pragma unroll
        for (int q = 0; q < 4; ++q) l1[q] = p[q] + b1[q];
        int gt = 0; float mx = l1[0];
#pragma unroll
        for (int q = 1; q < 4; ++q) if (l1[q] > mx) { mx = l1[q]; gt = q; }
        float se = 0.f;
#pragma unroll
        for (int q = 0; q < 4; ++q) se += expf_(l1[q] - mx);
        const float pg = 1.0f / se;
        float l2[4];
#pragma unroll
        for (int q = 0; q < 4; ++q) l2[q] = gt == 0 ? p[4 + q] + b2[q] : gt == 1 ? p[8 + q] + b2[4 + q] : gt == 2 ? p[12 + q] + b2[8 + q] : p[16 + q] + b2[12 + q];
        int i0 = 0; float v0 = l2[0];
#pragma unroll
        for (int q = 1; q < 4; ++q) if (l2[q] > v0) { v0 = l2[q]; i0 = q; }
        int i1 = -1; float v1 = -3.0e38f;
#pragma unroll
        for (int q = 0; q < 4; ++q) if (q != i0 && l2[q] > v1) { v1 = l2[q]; i1 = q; }
        const float e1 = expf_(v1 - v0), inv = 1.0f / (1.0f + e1);
        if (lane == 0) { wts[(size_t)row * 2] = inv * pg; wts[(size_t)row * 2 + 1] = e1 * inv * pg;
            ent[(row - rbase) * 2] = gt * 4 + i0; ent[(row - rbase) * 2 + 1] = gt * 4 + i1; }
    }
    __syncthreads();
    if (F.tid < NEXP) { const int e = F.tid, n2 = rows_per_wg * 2; int n = 0;
        for (int i = 0; i < n2; ++i) n += (ent[i] == e) ? 1 : 0;
        if (n > 0) { int pos = (int)__hip_atomic_fetch_add(gcnt + e, (unsigned)n, RLX_AGENT);
            for (int i = 0; i < n2; ++i) if (ent[i] == e) { list[(size_t)e * T + pos] = (rbase + (i >> 1)) * 2 + (i & 1); ++pos; } } }
    __syncthreads();
}
DI void gather_phase(const Frame& F, int l) {
    unsigned* gcnt = (unsigned*)(F.ws + WS_CTL) + CW_CNT + 64 * l;
    const int* list = (const int*)(F.ws + WS_LIST); const bf16_t* H = (const bf16_t*)(F.ws + WS_H); bf16_t* HS = (bf16_t*)(F.ws + WS_HS);
    int cnt[NEXP];
#pragma unroll
    for (int k = 0; k < NEXP; ++k) cnt[k] = (int)__builtin_amdgcn_readfirstlane(__hip_atomic_load(gcnt + k, RLX_AGENT));
    const int gw = F.vcu * NWAVES + F.wave, NGW = F.G * NWAVES, lane = F.lane;
    for (int r = gw; r < 2 * T; r += NGW) {
        int acc = 0, tp = 0, e = 0, p = 0, slot = 0;
#pragma unroll
        for (int k = 0; k < NEXP; ++k) { if (r >= acc && r < acc + cnt[k]) { e = k; p = r - acc; slot = tp * 256 + p; } acc += cnt[k]; tp += (cnt[k] + 255) >> 8; }
        const int tok = list[(size_t)e * T + p] >> 1;
        const u32x4* src = (const u32x4*)(H + (size_t)tok * 1024); u32x4* dst = (u32x4*)(HS + (size_t)slot * 1024);
        const u32x4 a = src[lane], bq = src[64 + lane]; dst[lane] = a; dst[64 + lane] = bq;
    }
}
DI void final_phase(const Frame& F) {
    const float* mod = (const float*)(F.ws + WS_MOD); const bf16_t* o2 = (const bf16_t*)(F.ws + WS_O2);
    const int rows_per_wg = T / F.G, rpw = rows_per_wg / NWAVES, lane = F.lane;
    const int row0 = F.vcu * rows_per_wg + F.wave * rpw, b = row0 / SEQ;
    f32x4 g2[4], fg[4];
#pragma unroll
    for (int j = 0; j < 4; ++j) { const int c = 4 * lane + 256 * j; g2[j] = *(const f32x4*)(mod + ((size_t)8 + b) * 6144 + 5 * 1024 + c); fg[j] = *(const f32x4*)(F.in[I_FG] + c); }
    for (int i = 0; i < rpw; ++i) {
        const int row = row0 + i; f32x4 x[4];
#pragma unroll
        for (int j = 0; j < 4; ++j) { x[j] = *(const f32x4*)(F.out + (size_t)row * 1024 + 4 * lane + 256 * j);
            const u32x2 a = *(const u32x2*)(o2 + ((size_t)row * 2) * 1024 + 4 * lane + 256 * j), bb = *(const u32x2*)(o2 + ((size_t)row * 2 + 1) * 1024 + 4 * lane + 256 * j);
            f32x4 o; o[0] = bf_lo(a.x) + bf_lo(bb.x); o[1] = bf_hi(a.x) + bf_hi(bb.x); o[2] = bf_lo(a.y) + bf_lo(bb.y); o[3] = bf_hi(a.y) + bf_hi(bb.y);
            if (DBG_NO_MOE) o = o * 0.f;
            x[j] += g2[j] * o; }
        float ss = 0.f;
#pragma unroll
        for (int j = 0; j < 4; ++j) ss += (x[j][0] * x[j][0] + x[j][1] * x[j][1]) + (x[j][2] * x[j][2] + x[j][3] * x[j][3]);
        const float rstd = 1.0f / sqrtf(wave_sum(ss) * (1.0f / 1024.0f) + EPS);
#pragma unroll
        for (int j = 0; j < 4; ++j) *(f32x4*)(F.out + (size_t)row * 1024 + 4 * lane + 256 * j) = x[j] * rstd * fg[j];
    }
}

namespace mix {
constexpr int QS = 0, KS = 32768, VS = 65536, PS = 98304, SS = 131072, SC = 147456;
constexpr int F_ALPHA = 0, F_BETA = 128, F_WV = 256, F_IW = 384, F_EMT = 512, F_RSUM = 640  , F_QN = 1664  , F_NST = 2176, F_NPART = 2304  , F_MISC = 2816;
DI unsigned offb(unsigned row, unsigned ch) { return 256u * row + 16u * (ch ^ (((row & 3) << 2) | ((row >> 2) & 3))); }
DI bf16x8 ldrow(LAS unsigned char* lds, int base, int row, int ch) { return *(const LAS bf16x8*)(lds + base + offb(row, ch)); }
DI bf16x8 ldtr(LAS unsigned char* lds, int base, int c, int ks, int lane) {
    const unsigned g = lane >> 4, q = (lane & 15) >> 2, p = lane & 3;
    const unsigned a0 = base + offb(32 * ks + 8 * g + q, 2 * c + (p >> 1)) + 8 * (p & 1);
    const unsigned a1 = base + offb(32 * ks + 8 * g + 4 + q, 2 * c + (p >> 1)) + 8 * (p & 1);
    const s16x4 lo = __builtin_amdgcn_ds_read_tr16_b64_v4i16((LAS s16x4*)(lds + a0));
    const s16x4 hi = __builtin_amdgcn_ds_read_tr16_b64_v4i16((LAS s16x4*)(lds + a1));
    return __builtin_shufflevector(lo, hi, 0, 1, 2, 3, 4, 5, 6, 7);
}
#define MFMA16(a, b, c) __builtin_amdgcn_mfma_f32_16x16x32_bf16((a), (b), (c), 0, 0, 0)

DI void mixer_phase(const Frame& F, int l) {
    LAS unsigned char* lds = F.lds; LAS float* sc = (LAS float*)(lds + SC);
    int tid = F.tid, lane = F.lane, w = F.wave, fr = lane & 15, fq = lane >> 4;
    bf16_t* P = (bf16_t*)(F.ws + WS_PROJ);
    const float* gates = (const float*)(F.ws + WS_GATES); const float* rope = (const float*)(F.ws + WS_ROPE);
    const float SCK = 0.08838834764831845f;
    for (int item = F.vcu; item < 256; item += F.G) {
        const int br = item >> 7, b = (item >> 4) & 7, h = (item >> 2) & 3, sl = item & 3;
        const bf16_t* qk = P + (size_t)(br ? PH_RQK : PH_MQK) * ((size_t)T * 1024);
        bf16_t* vb = P + (size_t)(br ? PH_RV : PH_MV) * ((size_t)T * 1024) + h * 256 + sl * 64;
        f32x4 st[4];
#pragma unroll
        for (int c = 0; c < 4; ++c) st[c] = (f32x4){0.f, 0.f, 0.f, 0.f};
        for (int i = tid; i < 16384 / 16; i += NTHR) *(LAS u32x4*)(lds + SS + 16 * i) = (u32x4){0u, 0u, 0u, 0u};
        if (tid < 128) { sc[F_NST + tid] = 0.f; }
        if (tid == 0) { sc[F_MISC + 1] = 0.f; }
        if (br == 1 && tid < 128) {
            const float lg = __logf(1.0f - exp2f(-5.0f - (float)h));
            sc[F_ALPHA + tid] = __expf(lg * (float)tid); sc[F_BETA + tid] = __expf(-lg * (float)tid) * SCK;
            sc[F_WV + tid] = __expf(lg * (float)(127 - tid)) * SCK; sc[F_IW + tid] = __expf(lg * (float)(tid + 1));
            if (tid == 0) sc[F_MISC] = __expf(lg * 128.0f);
        }
        int cm = tid >> 8, crb = (tid >> 4) & 15, ccg = tid & 15;
        int cch = cm * 512 + h * 128 + 8 * ccg;
        float cw[4][8], cbv[8];
        if (br == 0) {
#pragma unroll
            for (int j = 0; j < 4; ++j) { const f32x4 a = *(const f32x4*)(F.in[I_CONVW] + ((size_t)l * 4 + j) * 1024 + cch), bq = *(const f32x4*)(F.in[I_CONVW] + ((size_t)l * 4 + j) * 1024 + cch + 4);
                cw[j][0] = a[0]; cw[j][1] = a[1]; cw[j][2] = a[2]; cw[j][3] = a[3]; cw[j][4] = bq[0]; cw[j][5] = bq[1]; cw[j][6] = bq[2]; cw[j][7] = bq[3]; }
            const f32x4 a = *(const f32x4*)(F.in[I_CONVB] + (size_t)l * 1024 + cch), bq = *(const f32x4*)(F.in[I_CONVB] + (size_t)l * 1024 + cch + 4);
            cbv[0] = a[0]; cbv[1] = a[1]; cbv[2] = a[2]; cbv[3] = a[3]; cbv[4] = bq[0]; cbv[5] = bq[1]; cbv[6] = bq[2]; cbv[7] = bq[3];
        } else {
#pragma unroll
            for (int j = 0; j < 4; ++j)
#pragma unroll
                for (int e = 0; e < 8; ++e) cw[j][e] = 0.f;
#pragma unroll
            for (int e = 0; e < 8; ++e) cbv[e] = 0.f;
        }
        __syncthreads();
        for (int ch = 0; ch < SEQ / 128; ++ch) {
            const int t0 = b * SEQ + ch * 128;
            { int t_ = threadIdx.x; asm volatile("" : "+v"(t_)); tid = t_; lane = t_ & 63; w = __builtin_amdgcn_readfirstlane(t_ >> 6); fr = lane & 15; fq = lane >> 4;
              cm = tid >> 8; crb = (tid >> 4) & 15; ccg = tid & 15; cch = cm * 512 + h * 128 + 8 * ccg; }
            if (br == 0 && w == 0) {
                const float i0 = gates[(size_t)(t0 + 2 * lane) * 8 + h], i1 = gates[(size_t)(t0 + 2 * lane + 1) * 8 + h];
                const float f0 = gates[(size_t)(t0 + 2 * lane) * 8 + 4 + h], f1 = gates[(size_t)(t0 + 2 * lane + 1) * 8 + 4 + h];
                const float lf0 = fminf(f0, 0.f) - log1pf(__expf(-fabsf(f0))), lf1 = fminf(f1, 0.f) - log1pf(__expf(-fabsf(f1)));
                float incl = lf0 + lf1;
#pragma unroll
                for (int o = 1; o < 64; o <<= 1) { const float t = __shfl_up(incl, o); if (lane >= o) incl += t; }
                const float b1 = incl, b0 = incl - lf1;
                const float btot = __shfl(incl, 63);
                const float a0 = btot - b0 + i0, a1 = btot - b1 + i1;
                const float amax = wave_max(fmaxf(a0, a1));
                const float mprev = sc[F_MISC + 1];
                const float mnew = fmaxf(btot + mprev, amax);
                const float g0 = i0 - b0, g1 = i1 - b1;
                float pm = fmaxf(g0, g1);
#pragma unroll
                for (int o = 1; o < 64; o <<= 1) { const float t = __shfl_up(pm, o); if (lane >= o) pm = fmaxf(pm, t); }
                const float pmprev = __shfl_up(pm, 1);
                const float pm0 = lane == 0 ? g0 : fmaxf(pmprev, g0), pm1 = pm;
                const float mu = __shfl(pm, 63);
                const float M0 = fmaxf(mprev, pm0), M1 = fmaxf(mprev, pm1);
                f32x2 v;
                v.x = __expf(fminf(mu - M0, 80.f)); v.y = __expf(fminf(mu - M1, 80.f)); *(LAS f32x2*)(sc + F_ALPHA + 2 * lane) = v;
                v.x = __expf(g0 - mu) * SCK; v.y = __expf(g1 - mu) * SCK; *(LAS f32x2*)(sc + F_BETA + 2 * lane) = v;
                v.x = __expf(a0 - mnew) * SCK; v.y = __expf(a1 - mnew) * SCK; *(LAS f32x2*)(sc + F_WV + 2 * lane) = v;
                v.x = __expf(mprev - M0); v.y = __expf(mprev - M1); *(LAS f32x2*)(sc + F_IW + 2 * lane) = v;
                v.x = __expf(fminf(-(b0 + M0), 80.f)); v.y = __expf(fminf(-(b1 + M1), 80.f)); *(LAS f32x2*)(sc + F_EMT + 2 * lane) = v;
                if (lane == 0) { sc[F_MISC] = __expf(btot + mprev - mnew); sc[F_MISC + 1] = mnew; }
            }
            __syncthreads();
            if (br == 0) {
                u32x4 raw[11];
#pragma unroll
                for (int i = 0; i < 11; ++i) { const int rr = 8 * crb - 3 + i; const bool ok = (ch > 0) || (rr >= 0);
                    raw[i] = ok ? *(const u32x4*)(qk + (size_t)(t0 + rr) * 1024 + cch) : (u32x4){0u, 0u, 0u, 0u}; }
#pragma unroll
                for (int r = 0; r < 8; ++r) { float y[8];
#pragma unroll
                    for (int e = 0; e < 8; ++e) y[e] = cbv[e];
#pragma unroll
                    for (int j = 0; j < 4; ++j) { const u32x4 x = raw[r + j];
                        y[0] += cw[j][0] * bf_lo(x.x); y[1] += cw[j][1] * bf_hi(x.x); y[2] += cw[j][2] * bf_lo(x.y); y[3] += cw[j][3] * bf_hi(x.y);
                        y[4] += cw[j][4] * bf_lo(x.z); y[5] += cw[j][5] * bf_hi(x.z); y[6] += cw[j][6] * bf_lo(x.w); y[7] += cw[j][7] * bf_hi(x.w); }
                    u32x4 o; o.x = cvt_pk_bf16(siluf_(y[0]), siluf_(y[1])); o.y = cvt_pk_bf16(siluf_(y[2]), siluf_(y[3])); o.z = cvt_pk_bf16(siluf_(y[4]), siluf_(y[5])); o.w = cvt_pk_bf16(siluf_(y[6]), siluf_(y[7]));
                    *(LAS u32x4*)(lds + (cm ? KS : QS) + offb(8 * crb + r, ccg)) = o; }
            } else {
#pragma unroll
                for (int it = 0; it < 2; ++it) { const int pi = tid + NTHR * it, r = pi >> 3, cg = pi & 7; const size_t tok = (size_t)(t0 + r);
                    const f32x4 c0 = *(const f32x4*)(rope + tok * 128 + 8 * cg), c1 = *(const f32x4*)(rope + tok * 128 + 8 * cg + 4);
                    const f32x4 s0 = *(const f32x4*)(rope + tok * 128 + 64 + 8 * cg), s1 = *(const f32x4*)(rope + tok * 128 + 64 + 8 * cg + 4);
                    const float cs[8] = {c0[0], c0[1], c0[2], c0[3], c1[0], c1[1], c1[2], c1[3]}, sn[8] = {s0[0], s0[1], s0[2], s0[3], s1[0], s1[1], s1[2], s1[3]};
#pragma unroll
                    for (int mq = 0; mq < 2; ++mq) { const bf16_t* src = qk + tok * 1024 + mq * 512 + h * 128 + 8 * cg;
                        const u32x4 x1 = *(const u32x4*)src, x2 = *(const u32x4*)(src + 64);
                        const float a[8] = {bf_lo(x1.x), bf_hi(x1.x), bf_lo(x1.y), bf_hi(x1.y), bf_lo(x1.z), bf_hi(x1.z), bf_lo(x1.w), bf_hi(x1.w)};
                        const float d[8] = {bf_lo(x2.x), bf_hi(x2.x), bf_lo(x2.y), bf_hi(x2.y), bf_lo(x2.z), bf_hi(x2.z), bf_lo(x2.w), bf_hi(x2.w)};
                        float o1[8], o2[8];
#pragma unroll
                        for (int e = 0; e < 8; ++e) { o1[e] = a[e] * cs[e] - d[e] * sn[e]; o2[e] = a[e] * sn[e] + d[e] * cs[e]; }
                        u32x4 w1, w2; w1.x = cvt_pk_bf16(o1[0], o1[1]); w1.y = cvt_pk_bf16(o1[2], o1[3]); w1.z = cvt_pk_bf16(o1[4], o1[5]); w1.w = cvt_pk_bf16(o1[6], o1[7]);
                        w2.x = cvt_pk_bf16(o2[0], o2[1]); w2.y = cvt_pk_bf16(o2[2], o2[3]); w2.z = cvt_pk_bf16(o2[4], o2[5]); w2.w = cvt_pk_bf16(o2[6], o2[7]);
                        *(LAS u32x4*)(lds + (mq ? KS : QS) + offb(r, cg)) = w1; *(LAS u32x4*)(lds + (mq ? KS : QS) + offb(r, 8 + cg)) = w2; } }
            }
#pragma unroll
            for (int it = 0; it < 2; ++it) { const int pi = tid + NTHR * it, r = pi >> 3, cg = pi & 7;
                const u32x4 x = *(const u32x4*)(vb + (size_t)(t0 + r) * 1024 + 8 * cg); const float wv = sc[F_WV + r];
                u32x4 o; o.x = cvt_pk_bf16(bf_lo(x.x) * wv, bf_hi(x.x) * wv); o.y = cvt_pk_bf16(bf_lo(x.y) * wv, bf_hi(x.y) * wv); o.z = cvt_pk_bf16(bf_lo(x.z) * wv, bf_hi(x.z) * wv); o.w = cvt_pk_bf16(bf_lo(x.w) * wv, bf_hi(x.w) * wv);
                *(LAS u32x4*)(lds + VS + offb(r, cg)) = x; *(LAS u32x4*)(lds + VS + offb(r, 8 + cg)) = o; }
            __syncthreads();
            for (int tt = w; tt < 40; tt += NWAVES) {
                int ti = 0, tj = 0, acc0 = 0;
#pragma unroll
                for (int i = 0; i < 8; ++i) { const int n = i + 1 + ((i & 1) ^ 1); if (tt >= acc0 && tt < acc0 + n) { ti = i; tj = tt - acc0; } acc0 += n; }
                u32x2 pw = (u32x2){0u, 0u};
                if (tj <= ti) {
                    f32x4 a4 = (f32x4){0.f, 0.f, 0.f, 0.f};
#pragma unroll
                    for (int ks = 0; ks < 4; ++ks) a4 = MFMA16(ldrow(lds, KS, 16 * tj + fr, 4 * ks + fq), ldrow(lds, QS, 16 * ti + fr, 4 * ks + fq), a4);
                    const float al = sc[F_ALPHA + 16 * ti + fr]; const f32x4 be = *(const LAS f32x4*)(sc + F_BETA + 16 * tj + 4 * fq);
                    float p[4];
#pragma unroll
                    for (int r = 0; r < 4; ++r) { const float v = a4[r] * al * be[r]; p[r] = (ti == tj && (4 * fq + r) > fr) ? 0.f : v; }
                    float rs = (p[0] + p[1]) + (p[2] + p[3]); rs += __shfl_xor(rs, 16); rs += __shfl_xor(rs, 32);
                    if (fq == 0) sc[F_RSUM + tj * 128 + 16 * ti + fr] = rs;
                    pw.x = cvt_pk_bf16(p[0], p[1]); pw.y = cvt_pk_bf16(p[2], p[3]);
                }
                *(LAS u32x2*)(lds + PS + offb(16 * ti + fr, 2 * tj + (fq >> 1)) + 8 * (fq & 1)) = pw;
            }
            f32x4 cr[4];
            { bf16x8 bq[4];
#pragma unroll
              for (int ks = 0; ks < 4; ++ks) bq[ks] = ldrow(lds, QS, 16 * w + fr, 4 * ks + fq);
#pragma unroll
              for (int c = 0; c < 4; ++c) { cr[c] = (f32x4){0.f, 0.f, 0.f, 0.f};
#pragma unroll
                  for (int ks = 0; ks < 4; ++ks) cr[c] = MFMA16(ldrow(lds, SS, 16 * c + fr, 4 * ks + fq), bq[ks], cr[c]); } }
            if (br == 0) {
                { const int lrow = tid & 127, dq = tid >> 7; float s = 0.f;
#pragma unroll
                  for (int c4 = 0; c4 < 4; ++c4) { const bf16x8 v = ldrow(lds, QS, lrow, 4 * dq + c4);
#pragma unroll
                      for (int j = 0; j < 8; ++j) s += bf2f(v[j]) * sc[F_NST + 32 * dq + 8 * c4 + j]; }
                  sc[F_QN + dq * 128 + lrow] = s; }
                { const int d = tid & 127, sq = tid >> 7; float s = 0.f;
                  for (int r = 0; r < 32; ++r) { const int srow = 32 * sq + r; const unsigned short kv = *(const LAS unsigned short*)(lds + KS + offb(srow, d >> 3) + 2 * (d & 7));
                      s += sc[F_WV + srow] * __uint_as_float(((unsigned)kv) << 16); }
                  sc[F_NPART + sq * 128 + d] = s; }
            }
            __syncthreads();
            {
                f32x4 in[4];
                const int kmax = (w >> 1) + 1;
                bf16x8 bp[4];
#pragma unroll
                for (int ks = 0; ks < 4; ++ks) if (ks < kmax) bp[ks] = ldrow(lds, PS, 16 * w + fr, 4 * ks + fq);
#pragma unroll
                for (int c = 0; c < 4; ++c) { in[c] = (f32x4){0.f, 0.f, 0.f, 0.f};
#pragma unroll
                    for (int ks = 0; ks < 4; ++ks) if (ks < kmax) in[c] = MFMA16(ldtr(lds, VS, c, ks, lane), bp[ks], in[c]); }
                const int lrow = 16 * w + fr; const float iw = sc[F_IW + lrow];
                float scale = 1.0f;
                if (br == 0) { float den = 0.f;
                    for (int j = 0; j <= w; ++j) den += sc[F_RSUM + j * 128 + lrow];
                    den += iw * ((sc[F_QN + lrow] + sc[F_QN + 128 + lrow]) + (sc[F_QN + 256 + lrow] + sc[F_QN + 384 + lrow]));
                    scale = 1.0f / fmaxf(fabsf(den), sc[F_EMT + lrow]); }
#pragma unroll
                for (int c = 0; c < 4; ++c) { const f32x4 o = (in[c] + cr[c] * iw) * scale;
                    u32x2 wv; wv.x = cvt_pk_bf16(o[0], o[1]); wv.y = cvt_pk_bf16(o[2], o[3]);
                    *(u32x2*)(vb + (size_t)(t0 + lrow) * 1024 + 16 * c + 4 * fq) = wv; }
            }
            {
                const float decay = sc[F_MISC];
                bf16x8 ak[4];
#pragma unroll
                for (int ks = 0; ks < 4; ++ks) ak[ks] = ldtr(lds, KS, w, ks, lane);
#pragma unroll
                for (int c = 0; c < 4; ++c) { st[c] = st[c] * decay;
#pragma unroll
                    for (int ks = 0; ks < 4; ++ks) st[c] = MFMA16(ak[ks], ldtr(lds, VS, 4 + c, ks, lane), st[c]);
                    u32x2 wv; wv.x = cvt_pk_bf16(st[c][0], st[c][1]); wv.y = cvt_pk_bf16(st[c][2], st[c][3]);
                    *(LAS u32x2*)(lds + SS + offb(16 * c + fr, 2 * w + (fq >> 1)) + 8 * (fq & 1)) = wv; }
                if (br == 0 && tid < 128) sc[F_NST + tid] = decay * sc[F_NST + tid] + ((sc[F_NPART + tid] + sc[F_NPART + 128 + tid]) + (sc[F_NPART + 256 + tid] + sc[F_NPART + 384 + tid]));
            }
            __syncthreads();
        }
    }
}
}

constexpr int N_PHASES = 22;

template <int KIND> __global__ void __launch_bounds__(NTHR, 2) trunk_k(Args args) {
    extern __shared__ __attribute__((aligned(16))) unsigned char lds_raw[];
    Frame F;
    F.lds = (LAS unsigned char*)lds_raw;
    F.tid = threadIdx.x; F.lane = F.tid & 63; F.wave = __builtin_amdgcn_readfirstlane(F.tid >> 6);
    F.G = gridDim.x; { const int bx = blockIdx.x; F.vcu = (F.G % 8 == 0) ? (bx % 8) * (F.G / 8) + bx / 8 : bx; }
    F.in = args.in; F.out = args.out; F.ws = args.ws;
    volatile LAS unsigned* MISC = (volatile LAS unsigned*)(F.lds + MISC_OFF);
    if (F.tid < 64) MISC[F.tid] = 0u;
    __syncthreads();
    XcdBarrier bar; bar.bar = (unsigned*)(F.ws + WS_CTL) + CW_BAR; bar.x = 0; bar.st = nullptr;
    const bool one_launch = (args.ph_hi - args.ph_lo) > 1;
    if (one_launch) bar = xcd_barrier_post((unsigned*)(F.ws + WS_CTL) + CW_BAR, MISC + 8);

#define RELAUNDER() do { int t_ = threadIdx.x; asm volatile("" : "+v"(t_));     \
        F.tid = t_; F.lane = t_ & 63; F.wave = __builtin_amdgcn_readfirstlane(t_ >> 6); unsigned char* w_ = args.ws; asm volatile("" : "+s"(w_)); F.ws = w_; } while (0)
#define WANT(kind) (KIND < 0 || KIND == (kind))
    if (WANT(10) && args.ph_lo == 0) {
        RELAUNDER();
        mods_phase(F, F.in[I_C], F.in[I_WADA], F.in[I_BADA], (float*)(F.ws + WS_MOD));
        rope_phase(F, (const int*)F.in[I_POS], (float*)(F.ws + WS_ROPE));
        convert_weights(F, 0);
        if (args.ph_hi > 1) xcd_barrier(bar);
    }
    const int lo = args.ph_lo < 1 ? 1 : args.ph_lo, hi = args.ph_hi > N_PHASES - 1 ? N_PHASES - 1 : args.ph_hi;
    for (int ph = lo; ph < hi; ++ph) {
        const int l = (ph - 1) / 10, k = (ph - 1) % 10;
        if (KIND >= 0 && k != KIND) continue;
        RELAUNDER();
        bf16_t* P = (bf16_t*)(F.ws + WS_PROJ);
        const size_t PB = (size_t)T * 1024;
        if (k == 0) { if (l > 0) convert_weights(F, l); rp1_phase(F, l); }
        else if (k == 1) { DenseOrder<32> S{(const bf16_t*)(F.ws + WS_H), (const bf16_t*)(F.ws + WT_IN), (int)blockIdx.x}; EpiG1 E{P};
            pg8::gemm_phase<EpiG1, DenseOrder<32>, true, true>(F.lds, F.tid, 1024, S, E); }
        else if (k == 2) { mix::mixer_phase(F, l); }
        else if (k == 3) { norm_phase(F); }
        else if (k == 4) { BranchOrder S{P + PH_MV * PB, P + PH_RV * PB, (const bf16_t*)(F.ws + WT_BM), (const bf16_t*)(F.ws + WT_BR), (int)blockIdx.x};
            EpiBr E{P + PH_GA * PB, P + PH_GB * PB, (float*)(F.ws + WS_T1), (bf16_t*)(F.ws + WS_Y)};
            pg8::gemm_phase<EpiBr, BranchOrder, true, true>(F.lds, F.tid, 1024, S, E); }
        else if (k == 5) { DenseOrder<4> S{(const bf16_t*)(F.ws + WS_Y), (const bf16_t*)(F.ws + WT_OUT), (int)blockIdx.x};
            EpiOut E{l == 0 ? F.in[I_X] : F.out, F.out, (const float*)(F.ws + WS_MOD) + (size_t)l * 8 * 6144};
            pg8::gemm_phase<EpiOut, DenseOrder<4>, true, true>(F.lds, F.tid, 1024, S, E); }
        else if (k == 6) { rp2_phase(F, l); }
        else if (k == 7) { gather_phase(F, l); }
        else if (k == 8) { MoeOrder S{(const bf16_t*)(F.ws + WS_HS), (const bf16_t*)(F.ws + WT_GU), (size_t)1024 * 1024, (const unsigned*)(F.ws + WS_CTL) + CW_CNT + 64 * l, (int)blockIdx.x};
            EpiGU E{(bf16_t*)(F.ws + WS_HE)};
            pg8::gemm_phase<EpiGU, MoeOrder, true, true>(F.lds, F.tid, 1024, S, E); }
        else { MoeOrder S{(const bf16_t*)(F.ws + WS_HE), (const bf16_t*)(F.ws + WT_DN), (size_t)1024 * DFF, (const unsigned*)(F.ws + WS_CTL) + CW_CNT + 64 * l, (int)blockIdx.x};
            EpiDN E{(const int*)(F.ws + WS_LIST), (const float*)(F.ws + WS_WTS), (bf16_t*)(F.ws + WS_O2)};
            pg8::gemm_phase<EpiDN, MoeOrder, true, true>(F.lds, F.tid, DFF, S, E); }
        if (ph + 1 < args.ph_hi) xcd_barrier(bar);
    }
    if (WANT(11) && args.ph_hi == N_PHASES) { RELAUNDER(); final_phase(F); }
#undef RELAUNDER
#undef WANT
}

typedef void (*KernFn)(Args);
template <int K> static KernFn kern_of() { return trunk_k<K>; }
static KernFn kind_fn(int kind) {
    switch (kind) { case 0: return kern_of<0>(); case 1: return kern_of<1>(); case 2: return kern_of<2>(); case 3: return kern_of<3>(); case 4: return kern_of<4>(); case 5: return kern_of<5>();
                    case 6: return kern_of<6>(); case 7: return kern_of<7>(); case 8: return kern_of<8>(); case 9: return kern_of<9>(); case 10: return kern_of<10>(); default: return kern_of<11>(); }
}
extern "C" void kernel_launch(void* const* d_in, const int* in_sizes, int n_in, void* d_out, int out_size, void* d_ws, size_t ws_size, hipStream_t stream) {
    static int grid = 0;
    if (grid == 0) {
        if (n_in != N_IN || out_size != T * D || ws_size < WS_END) { fprintf(stderr, "kernel_launch: unexpected shapes (n_in %d, out %d, ws %zu; need ws >= %zu)\n", n_in, out_size, ws_size, (size_t)WS_END); grid = -1; return; }
        int dev = 0, cus = 0, per_cu = 0;
        if (hipGetDevice(&dev) != hipSuccess || hipDeviceGetAttribute(&cus, hipDeviceAttributeMultiprocessorCount, dev) != hipSuccess) { grid = -1; return; }
#if MK_N_LAUNCHES == 1
        if (hipFuncSetAttribute((const void*)trunk_k<-1>, hipFuncAttributeMaxDynamicSharedMemorySize, LDS_BYTES) != hipSuccess) { fprintf(stderr, "kernel_launch: hipFuncSetAttribute failed\n"); grid = -1; return; }
        if (hipOccupancyMaxActiveBlocksPerMultiprocessor(&per_cu, (const void*)trunk_k<-1>, NTHR, LDS_BYTES) != hipSuccess || per_cu < 1) { fprintf(stderr, "kernel_launch: occupancy query says %d\n", per_cu); (void)hipGetLastError(); grid = -1; return; }
#else
        for (int k = 0; k < 12; ++k) if (hipFuncSetAttribute((const void*)kind_fn(k), hipFuncAttributeMaxDynamicSharedMemorySize, LDS_BYTES) != hipSuccess) { fprintf(stderr, "kernel_launch: hipFuncSetAttribute failed\n"); grid = -1; return; }
        per_cu = 1;
#endif
        if (cus != GRID) { fprintf(stderr, "kernel_launch: %d CUs; this build needs exactly %d\n", cus, GRID); grid = -1; return; }
        grid = cus;
    }
    if (grid < 0) return;
    (void)hipMemsetAsync((char*)d_ws + WS_CTL, 0, CTL_ZERO_BYTES, stream);
    Args a{};
    for (int i = 0; i < N_IN; ++i) a.in[i] = (const float*)d_in[i];
    a.out = (float*)d_out; a.ws = (unsigned char*)d_ws;
#if MK_N_LAUNCHES == 1
    a.ph_lo = 0; a.ph_hi = N_PHASES;
    void* kargs[] = {&a};
    hipError_t e = hipLaunchCooperativeKernel((const void*)trunk_k<-1>, dim3(grid), dim3(NTHR), kargs, LDS_BYTES, stream);
    if (e != hipSuccess) fprintf(stderr, "kernel_launch: cooperative launch failed: %s\n", hipGetErrorString(e));
#else
    for (int ph = 0; ph < N_PHASES; ++ph) { a.ph_lo = ph; a.ph_hi = ph + 1; const int kind = ph == 0 ? 10 : ph == N_PHASES - 1 ? 11 : (ph - 1) % 10;
        hipLaunchKernelGGL(kind_fn(kind), dim3(grid), dim3(NTHR), LDS_BYTES, stream, a); }
#endif
}
```

```cpp
#include <hip/hip_runtime.h>
#include <cstdio>
#include <cstdint>

#ifndef MK_N_LAUNCHES
#define MK_N_LAUNCHES 1
#endif
#ifndef DBG_NO_MOE
#define DBG_NO_MOE 0
#endif
#ifndef DBG_SKIP_MIXER
#define DBG_SKIP_MIXER 0
#endif
#ifndef DBG_REPEAT
#define DBG_REPEAT 0
#endif
#ifndef DBG_PROBE
#define DBG_PROBE -1
#endif
#ifndef DBG_NO_MIX
#define DBG_NO_MIX 0
#endif

#define LAS __attribute__((address_space(3)))
#define GAS __attribute__((address_space(1)))
typedef unsigned short bf16_t;
typedef short bf16x8 __attribute__((ext_vector_type(8)));
typedef short s16x4 __attribute__((ext_vector_type(4)));
typedef float f32x4 __attribute__((ext_vector_type(4)));
typedef float f32x2 __attribute__((ext_vector_type(2)));
typedef unsigned u32x4 __attribute__((ext_vector_type(4)));
typedef unsigned u32x2 __attribute__((ext_vector_type(2)));
#define DI __device__ __forceinline__

constexpr int NB = 8, SEQ = 2048, D = 1024, T = NB * SEQ, DIN = 8200, NEXP = 16, DFF = 512;
constexpr float EPS = 1e-6f;
constexpr int NWAVES = 8, NTHR = 512;

constexpr size_t MiB = 1u << 20;
constexpr size_t WS_CTL = 0, CTL_ZERO_BYTES = 1 * MiB;
constexpr size_t WS_MOD = 1 * MiB;
constexpr size_t WS_GATES = 2 * MiB;
constexpr size_t WS_WTS = 3 * MiB;
constexpr size_t WS_LIST = 4 * MiB;
constexpr size_t WS_ROPE = 5 * MiB;
constexpr size_t WS_TS = 13 * MiB;
constexpr size_t WS_NG = 14 * MiB;
constexpr size_t WS_SG = 38 * MiB;
constexpr size_t WS_WT = 16 * MiB;
constexpr size_t WT_IN = WS_WT, WT_BM = WS_WT + 16 * MiB, WT_BR = WS_WT + 18 * MiB, WT_OUT = WS_WT + 20 * MiB, WT_GU = WS_WT + 22 * MiB, WT_DN = WS_WT + 54 * MiB;
constexpr size_t WS_H = 86 * MiB;
constexpr size_t WS_PROJ = 118 * MiB;
constexpr size_t PBLK = 32 * MiB;
constexpr int PH_MQK = 0, PH_RQK = 1, PH_MV = 2, PH_RV = 3, PH_MO = 4, PH_RG = 5, PH_GA = 6, PH_GB = 7;
constexpr size_t WS_T1 = WS_PROJ;
constexpr size_t WS_HS = WS_PROJ;
constexpr size_t WS_HE = WS_PROJ + 3 * PBLK;
constexpr size_t WS_O2 = WS_PROJ + 5 * PBLK;
constexpr size_t WS_Y = WS_PROJ + 4 * PBLK;
constexpr size_t WS_END = WS_PROJ + 8 * PBLK;
constexpr int CW_CNT = 256;
constexpr int CW_BAR = 4096;

constexpr int LDS_BYTES = 163840;
constexpr int MISC_OFF = LDS_BYTES - 256;

typedef __bf16 bf16x2_t __attribute__((ext_vector_type(2)));
DI unsigned cvt_pk_bf16(float lo, float hi) { bf16x2_t v; v[0] = (__bf16)lo; v[1] = (__bf16)hi; return __builtin_bit_cast(unsigned, v); }
DI float bf_lo(unsigned u) { return __uint_as_float(u << 16); }
DI float bf_hi(unsigned u) { return __uint_as_float(u & 0xffff0000u); }
DI float bf2f(short s) { return __uint_as_float(((unsigned)(unsigned short)s) << 16); }
DI float sigmoidf_(float x) { return __builtin_amdgcn_rcpf(1.f + __builtin_amdgcn_exp2f(-1.44269504f * x)); }
DI float siluf_(float x) { return x * sigmoidf_(x); }
DI float expf_(float x) { return __builtin_amdgcn_exp2f(1.44269504f * x); }
template <int CTRL> DI float dppf(float v) { return __builtin_bit_cast(float, __builtin_amdgcn_update_dpp(0, __builtin_bit_cast(int, v), CTRL, 0xf, 0xf, true)); }
DI float rdl(float v, int l) { return __builtin_bit_cast(float, __builtin_amdgcn_readlane(__builtin_bit_cast(int, v), l)); }
DI float wave_sum(float v) {
    v += dppf<0xB1>(v); v += dppf<0x4E>(v); v += dppf<0x141>(v); v += dppf<0x140>(v);
    return (rdl(v, 0) + rdl(v, 16)) + (rdl(v, 32) + rdl(v, 48));
}
DI float wave_max(float v) {
    v = fmaxf(v, dppf<0xB1>(v)); v = fmaxf(v, dppf<0x4E>(v)); v = fmaxf(v, dppf<0x141>(v)); v = fmaxf(v, dppf<0x140>(v));
    return fmaxf(fmaxf(rdl(v, 0), rdl(v, 16)), fmaxf(rdl(v, 32), rdl(v, 48)));
}
DI float lane_get(float v, int src_lane) { return __builtin_bit_cast(float, __builtin_amdgcn_ds_bpermute(src_lane << 2, __builtin_bit_cast(int, v))); }
DI float shfl_up_l(float v, int o, int lane) { return lane_get(v, lane >= o ? lane - o : lane); }
DI float shfl_xor_l(float v, int m, int lane) { return lane_get(v, lane ^ m); }
DI int lane_id() { int l; asm volatile("v_mbcnt_lo_u32_b32 %0, -1, 0\n\tv_mbcnt_hi_u32_b32 %0, -1, %0" : "=v"(l)); return l; }
#define LDS_WAIT() asm volatile("s_waitcnt lgkmcnt(0)" ::: "memory")
#define VM_WAIT() asm volatile("s_waitcnt vmcnt(0)" ::: "memory")
#define RLX_AGENT __ATOMIC_RELAXED, __HIP_MEMORY_SCOPE_AGENT

namespace pg8 {
constexpr int BM = 256, BK = 64, HALF = 128, HTB = HALF * BK * 2, STAGE_BYTES = 8 * HTB, NXCD = 8, WGM = 8;
__host__ __device__ __forceinline__ int lds_byte(int r, int c) { const int st = (r >> 4) * 2 + (c >> 5), rr = r & 15, cc = c & 31, ob = rr * 64 + cc * 2; return st * 1024 + (ob ^ (((ob >> 9) & 1) << 5)); }
__host__ __device__ __forceinline__ void stage_rc(int b, int& R, int& C) { const int st = b / 1024, sb = b % 1024, swz = sb ^ (((sb >> 9) & 1) << 5); R = (st >> 1) * 16 + swz / 64; C = (st & 1) * 32 + (swz % 64) / 2; }
__host__ __device__ __forceinline__ int perm32(int rho) { const int n = rho >> 4, i = rho & 15; return 8 * (i >> 2) + 4 * n + (i & 3); }

struct Unit { int pm, pn; const bf16_t* A; const bf16_t* Bt; int x0, x1, x2; };

template <int nM, int nN, int G>
DI bool static_tile(int i, int c, int& pm, int& pn) {
    constexpr int nwg = nM * nN; const int L = i * G + c; if (L >= nwg) return false;
    int wgid = L; { constexpr int q = nwg / NXCD, r = nwg % NXCD; const int xcd = wgid % NXCD, off = wgid / NXCD; wgid = (xcd < r ? xcd * (q + 1) : r * (q + 1) + (xcd - r) * q) + off; }
    constexpr int nig = WGM * nN; const int gid = wgid / nig, fm = gid * WGM, gsz = (nM - fm) < WGM ? (nM - fm) : WGM;
    static_assert(nM % WGM == 0, "row tiles in groups of 8");
    pm = fm + ((wgid % nig) % WGM); pn = (wgid % nig) / WGM; (void)gsz; return true;
}

template <class Epi, class Sched, bool ALIGN_EPI, bool SP2>
DI void gemm_phase(LAS unsigned char* lds, const int tid, const int K, const Sched& S, const Epi& E) {
    const int wid = __builtin_amdgcn_readfirstlane(tid >> 6), lane = tid & 63, wr = wid >> 2, wc = wid & 3, fr = lane & 15, fq = lane >> 4;
    const int nt = K / BK;
    unsigned voffA[2], voffB[2];
    unsigned opq; asm volatile("v_mov_b32 %0, 0" : "=v"(opq));
#pragma unroll
    for (int i = 0; i < 2; ++i) { int R, C; stage_rc(tid * 16 + i * 8192, R, C); const int Rb = Epi::PERM ? ((R & ~31) + perm32(R & 31)) : R;
        voffA[i] = (unsigned)(R * K + C) * 2u + opq; voffB[i] = (unsigned)(Rb * K + C) * 2u + opq; }
    const size_t kstep = (size_t)(BK * 2);
    const size_t hstep = (size_t)HALF * K * 2;
    const size_t tstep = 2 * hstep;
    const unsigned ldsw = (unsigned)wid * 1024u;
    const int aoff = lds_byte(wr * 64 + fr, fq * 8), boff = lds_byte(wc * 32 + fr, fq * 8);
#define PG8_SA(b, h) (((b) * 2 + (h)) * HTB)
#define PG8_SB(b, h) ((4 + (b) * 2 + (h)) * HTB)
#define PG8_STAGE(bufoff, gbase, voff) do { _Pragma("unroll") for (int _i = 0; _i < 2; ++_i) \
        __builtin_amdgcn_global_load_lds((const unsigned*)((const char*)(gbase) + (voff)[_i]), (LAS unsigned*)(lds + (bufoff) + ldsw + _i * 8192), 16, 0, 0); } while (0)
#define PG8_LDA(dst, b, h) do { _Pragma("unroll") for (int m = 0; m < 4; ++m) _Pragma("unroll") for (int k = 0; k < 2; ++k) dst[m][k] = *(const LAS bf16x8*)(lds + PG8_SA(b, h) + aoff + m * 2048 + k * 1024); } while (0)
#define PG8_LDB(dst, b, h) do { _Pragma("unroll") for (int n = 0; n < 2; ++n) _Pragma("unroll") for (int k = 0; k < 2; ++k) dst[n][k] = *(const LAS bf16x8*)(lds + PG8_SB(b, h) + boff + n * 2048 + k * 1024); } while (0)
#define PG8_MMA(ai, bj, At, Bt) do { __builtin_amdgcn_s_setprio(1); _Pragma("unroll") for (int m = 0; m < 4; ++m) _Pragma("unroll") for (int n = 0; n < 2; ++n) _Pragma("unroll") for (int k = 0; k < 2; ++k) \
        acc[ai][bj][m][n] = __builtin_amdgcn_mfma_f32_16x16x32_bf16(Bt[n][k], At[m][k], acc[ai][bj][m][n], 0, 0, 0); __builtin_amdgcn_s_setprio(0); } while (0)
#define PG8_WAIT_V(n) asm volatile("s_waitcnt vmcnt(" #n ")" ::: "memory")
#define PG8_WAIT_L(n) asm volatile("s_waitcnt lgkmcnt(" #n ")" ::: "memory")
#define PG8_BAR __builtin_amdgcn_s_barrier()
#define PG8_SCHED __builtin_amdgcn_sched_barrier(0)
    Unit cur, nxt; int ui = 0;
    if (!S.next(0, cur)) return;
    f32x4 acc[2][2][4][2];
#pragma unroll
    for (int a = 0; a < 2; ++a)
#pragma unroll
        for (int b = 0; b < 2; ++b)
#pragma unroll
            for (int m = 0; m < 4; ++m)
#pragma unroll
                for (int n = 0; n < 2; ++n) acc[a][b][m][n] = (f32x4){0.f, 0.f, 0.f, 0.f};
    bf16x8 At[4][2], B0[2][2], B1[2][2];
    const char* cA = (const char*)cur.A + (size_t)cur.pm * tstep; const char* cB = (const char*)cur.Bt + (size_t)cur.pn * tstep;
    if constexpr (SP2) {
        PG8_STAGE(PG8_SB(0, 0), cB, voffB); PG8_STAGE(PG8_SB(0, 1), cB + hstep, voffB); PG8_STAGE(PG8_SA(0, 0), cA, voffA); PG8_STAGE(PG8_SA(0, 1), cA + hstep, voffA);
        if (wr == 1) PG8_BAR;
        PG8_WAIT_V(2); PG8_BAR;
        PG8_STAGE(PG8_SB(1, 0), cB + kstep, voffB); PG8_STAGE(PG8_SA(1, 0), cA + kstep, voffA); PG8_STAGE(PG8_SB(1, 1), cB + hstep + kstep, voffB);
        PG8_WAIT_V(6); PG8_BAR;
    } else {
        PG8_STAGE(PG8_SB(0, 0), cB, voffB); PG8_STAGE(PG8_SA(0, 0), cA, voffA); PG8_STAGE(PG8_SB(0, 1), cB + hstep, voffB); PG8_STAGE(PG8_SA(0, 1), cA + hstep, voffA);
        if (wr == 1) PG8_BAR;
        PG8_WAIT_V(4); PG8_BAR;
        PG8_STAGE(PG8_SB(1, 0), cB + kstep, voffB); PG8_STAGE(PG8_SA(1, 0), cA + kstep, voffA); PG8_STAGE(PG8_SB(1, 1), cB + hstep + kstep, voffB);
        PG8_WAIT_V(6); PG8_BAR;
    }
    for (;;) {
        const bool has_next = S.next(ui + 1, nxt);
        const char* nA = has_next ? (const char*)nxt.A + (size_t)nxt.pm * tstep : cA; const char* nB = has_next ? (const char*)nxt.Bt + (size_t)nxt.pn * tstep : cB;
        for (int t = 0; t < nt; t += 2) {
            const bool last = (t == nt - 2);
            const char* a1 = cA + (size_t)(t + 1) * kstep;
            const char* a2 = last ? nA : cA + (size_t)(t + 2) * kstep; const char* b2 = last ? nB : cB + (size_t)(t + 2) * kstep;
            const char* a3 = a2 + kstep; const char* b3 = b2 + kstep;
            if constexpr (SP2) {
            PG8_LDB(B0, 0, 0); PG8_LDB(B1, 0, 1); PG8_SCHED; PG8_LDA(At, 0, 0); PG8_STAGE(PG8_SA(1, 1), a1 + hstep, voffA);
            PG8_WAIT_V(8); PG8_WAIT_L(0); PG8_BAR; PG8_MMA(0, 0, At, B0); PG8_MMA(0, 1, At, B1); PG8_BAR; PG8_SCHED;
            PG8_LDA(At, 0, 1); PG8_STAGE(PG8_SB(0, 0), b2, voffB); PG8_STAGE(PG8_SB(0, 1), b2 + hstep, voffB); PG8_STAGE(PG8_SA(0, 0), a2, voffA);
            PG8_WAIT_V(8); PG8_WAIT_L(0); PG8_BAR; PG8_MMA(1, 0, At, B0); PG8_MMA(1, 1, At, B1); PG8_BAR; PG8_SCHED;
            PG8_LDB(B0, 1, 0); PG8_LDB(B1, 1, 1); PG8_SCHED; PG8_LDA(At, 1, 0); PG8_STAGE(PG8_SA(0, 1), a2 + hstep, voffA);
            PG8_WAIT_V(8); PG8_WAIT_L(0); PG8_BAR; PG8_MMA(0, 0, At, B0); PG8_MMA(0, 1, At, B1); PG8_BAR; PG8_SCHED;
            PG8_LDA(At, 1, 1); PG8_STAGE(PG8_SB(1, 0), b3, voffB); PG8_STAGE(PG8_SB(1, 1), b3 + hstep, voffB); PG8_STAGE(PG8_SA(1, 0), a3, voffA);
            PG8_WAIT_V(8); PG8_WAIT_L(0); PG8_BAR; PG8_MMA(1, 0, At, B0); PG8_MMA(1, 1, At, B1); PG8_BAR; PG8_SCHED;
            } else {
            PG8_LDB(B0, 0, 0); PG8_SCHED; PG8_LDA(At, 0, 0); PG8_STAGE(PG8_SA(1, 1), a1 + hstep, voffA);
            PG8_WAIT_L(8); PG8_BAR; PG8_WAIT_L(0); PG8_MMA(0, 0, At, B0); PG8_BAR; PG8_SCHED;
            PG8_LDB(B1, 0, 1); PG8_STAGE(PG8_SB(0, 0), b2, voffB);
            PG8_BAR; PG8_WAIT_L(0); PG8_MMA(0, 1, At, B1); PG8_BAR;
            PG8_LDA(At, 0, 1); PG8_STAGE(PG8_SA(0, 0), a2, voffA);
            PG8_BAR; PG8_WAIT_L(0); PG8_MMA(1, 0, At, B0); PG8_BAR; PG8_SCHED;
            PG8_STAGE(PG8_SB(0, 1), b2 + hstep, voffB);
            PG8_WAIT_V(6); PG8_BAR; PG8_MMA(1, 1, At, B1); PG8_BAR;
            PG8_LDB(B0, 1, 0); PG8_SCHED; PG8_LDA(At, 1, 0); PG8_STAGE(PG8_SA(0, 1), a2 + hstep, voffA);
            PG8_WAIT_L(8); PG8_BAR; PG8_WAIT_L(0); PG8_MMA(0, 0, At, B0); PG8_BAR; PG8_SCHED;
            PG8_LDB(B1, 1, 1); PG8_STAGE(PG8_SB(1, 0), b3, voffB);
            PG8_BAR; PG8_WAIT_L(0); PG8_MMA(0, 1, At, B1); PG8_BAR;
            PG8_LDA(At, 1, 1); PG8_STAGE(PG8_SA(1, 0), a3, voffA);
            PG8_BAR; PG8_WAIT_L(0); PG8_MMA(1, 0, At, B0); PG8_BAR; PG8_SCHED;
            PG8_STAGE(PG8_SB(1, 1), b3 + hstep, voffB);
            PG8_WAIT_V(6); PG8_BAR; PG8_MMA(1, 1, At, B1); PG8_BAR;
            }
        }
        if constexpr (ALIGN_EPI) { if (wr == 0) PG8_BAR; }
        E(acc, cur, wr, wc, fr, fq);
        if (!has_next) break;
#pragma unroll
        for (int a = 0; a < 2; ++a)
#pragma unroll
            for (int b = 0; b < 2; ++b)
#pragma unroll
                for (int m = 0; m < 4; ++m)
#pragma unroll
                    for (int n = 0; n < 2; ++n) acc[a][b][m][n] = (f32x4){0.f, 0.f, 0.f, 0.f};
        cur = nxt; cA = nA; cB = nB; ++ui;
        if constexpr (ALIGN_EPI) { if (wr == 1) PG8_BAR; }
    }
    PG8_WAIT_V(0);
    if constexpr (!ALIGN_EPI) { if (wr == 0) PG8_BAR; }
    PG8_BAR;
#undef PG8_SA
#undef PG8_SB
#undef PG8_STAGE
#undef PG8_LDA
#undef PG8_LDB
#undef PG8_MMA
#undef PG8_WAIT_V
#undef PG8_WAIT_L
#undef PG8_BAR
#undef PG8_SCHED
}
}

typedef f32x4 AccT[2][2][4][2];
using pg8::Unit;


struct EpiG1 {
    static constexpr bool PERM = true;
    bf16_t* proj;
    DI void operator()(const AccT& acc, const Unit& u, int wr, int wc, int fr, int fq) const {
        const int lb = u.pn >> 2;
        const int phys = lb == 0 ? PH_MQK : lb == 1 ? PH_MV : lb == 2 ? PH_MO : lb == 3 ? PH_RQK : lb == 4 ? PH_RV : lb == 5 ? PH_RG : lb == 6 ? PH_GA : PH_GB;
        const int act = (lb == 2 || lb == 6 || lb == 7) ? 1 : (lb == 5 ? 2 : 0);
        bf16_t* base = proj + (size_t)phys * ((size_t)T * 1024);
        const int row0 = u.pm * 256 + wr * 64 + fr, col0 = (u.pn & 3) * 256 + wc * 32 + 8 * fq;
#pragma unroll
        for (int ai = 0; ai < 2; ++ai)
#pragma unroll
            for (int m = 0; m < 4; ++m) { bf16_t* rowp = base + (size_t)(row0 + ai * 128 + m * 16) * 1024 + col0;
#pragma unroll
                for (int bj = 0; bj < 2; ++bj) { f32x4 v0 = acc[ai][bj][m][0], v1 = acc[ai][bj][m][1];
                    if (act == 1) {
#pragma unroll
                        for (int i = 0; i < 4; ++i) { v0[i] = sigmoidf_(v0[i]); v1[i] = sigmoidf_(v1[i]); }
                    } else if (act == 2) {
#pragma unroll
                        for (int i = 0; i < 4; ++i) { v0[i] = siluf_(v0[i]); v1[i] = siluf_(v1[i]); }
                    }
                    u32x4 w; w.x = cvt_pk_bf16(v0[0], v0[1]); w.y = cvt_pk_bf16(v0[2], v0[3]); w.z = cvt_pk_bf16(v1[0], v1[1]); w.w = cvt_pk_bf16(v1[2], v1[3]);
                    *(u32x4*)(rowp + bj * 128) = w; }
                asm volatile("" ::: "memory"); }
    }
};
struct EpiBr {
    static constexpr bool PERM = true;
    const bf16_t* ga; const bf16_t* gb; float* t1; bf16_t* y;
    DI void operator()(const AccT& acc, const Unit& u, int wr, int wc, int fr, int fq) const {
        const int row0 = u.pm * 256 + wr * 64 + fr, col0 = u.pn * 256 + wc * 32 + 8 * fq;
        const bf16_t* g = u.x0 ? gb : ga;
#pragma unroll
        for (int ai = 0; ai < 2; ++ai)
#pragma unroll
            for (int m = 0; m < 4; ++m) { const size_t off = (size_t)(row0 + ai * 128 + m * 16) * 1024 + col0;
#pragma unroll
                for (int bj = 0; bj < 2; ++bj) { const u32x4 gw = *(const u32x4*)(g + off + bj * 128);
                    f32x4 v0 = acc[ai][bj][m][0], v1 = acc[ai][bj][m][1];
                    v0[0] *= bf_lo(gw.x); v0[1] *= bf_hi(gw.x); v0[2] *= bf_lo(gw.y); v0[3] *= bf_hi(gw.y);
                    v1[0] *= bf_lo(gw.z); v1[1] *= bf_hi(gw.z); v1[2] *= bf_lo(gw.w); v1[3] *= bf_hi(gw.w);
                    if (u.x0 == 0) { *(f32x4*)(t1 + off + bj * 128) = v0; *(f32x4*)(t1 + off + bj * 128 + 4) = v1; }
                    else { const f32x4 p0 = *(const f32x4*)(t1 + off + bj * 128), p1 = *(const f32x4*)(t1 + off + bj * 128 + 4); v0 += p0; v1 += p1;
                        u32x4 w; w.x = cvt_pk_bf16(v0[0], v0[1]); w.y = cvt_pk_bf16(v0[2], v0[3]); w.z = cvt_pk_bf16(v1[0], v1[1]); w.w = cvt_pk_bf16(v1[2], v1[3]);
                        *(u32x4*)(y + off + bj * 128) = w; } }
                asm volatile("" ::: "memory"); }
    }
};
struct EpiOut {
    static constexpr bool PERM = false;
    const float* base; float* out; const float* g1;
    DI void operator()(const AccT& acc, const Unit& u, int wr, int wc, int fr, int fq) const {
        const int row0 = u.pm * 256 + wr * 64 + fr, col0 = u.pn * 256 + wc * 32 + 4 * fq;
        const float* gp = g1 + (size_t)(u.pm >> 3) * 6144 + 2048 + col0;
        f32x4 gv[2][2];
#pragma unroll
        for (int bj = 0; bj < 2; ++bj)
#pragma unroll
            for (int n = 0; n < 2; ++n) gv[bj][n] = *(const f32x4*)(gp + bj * 128 + n * 16);
#pragma unroll
        for (int ai = 0; ai < 2; ++ai)
#pragma unroll
            for (int m = 0; m < 4; ++m) { const size_t off = (size_t)(row0 + ai * 128 + m * 16) * 1024 + col0;
#pragma unroll
                for (int bj = 0; bj < 2; ++bj)
#pragma unroll
                    for (int n = 0; n < 2; ++n) { const f32x4 bs = *(const f32x4*)(base + off + bj * 128 + n * 16);
                        *(f32x4*)(out + off + bj * 128 + n * 16) = DBG_NO_MIX ? bs : bs + gv[bj][n] * acc[ai][bj][m][n]; }
                asm volatile("" ::: "memory"); }
    }
};
struct EpiGU {
    static constexpr bool PERM = false;
    bf16_t* he;
    DI void operator()(const AccT& acc, const Unit& u, int wr, int wc, int fr, int fq) const {
        const int row0 = u.pm * 256 + wr * 64 + fr;
#pragma unroll
        for (int ai = 0; ai < 2; ++ai)
#pragma unroll
            for (int m = 0; m < 4; ++m) { bf16_t* rowp = he + (size_t)(row0 + ai * 128 + m * 16) * DFF;
#pragma unroll
                for (int bj = 0; bj < 2; ++bj) { const int ff0 = 16 * (8 * u.pn + 4 * bj + wc) + 4 * fq;
                    const f32x4 g = acc[ai][bj][m][0], up = acc[ai][bj][m][1];
                    u32x2 w; w.x = cvt_pk_bf16(siluf_(g[0]) * up[0], siluf_(g[1]) * up[1]); w.y = cvt_pk_bf16(siluf_(g[2]) * up[2], siluf_(g[3]) * up[3]);
                    *(u32x2*)(rowp + ff0) = w; } }
    }
};
struct EpiDN {
    static constexpr bool PERM = true;
    const int* list; const float* wts; bf16_t* o2;
    DI void operator()(const AccT& acc, const Unit& u, int wr, int wc, int fr, int fq) const {
        const int p0 = u.x1 * 256 + wr * 64 + fr, col0 = u.pn * 256 + wc * 32 + 8 * fq;
#pragma unroll
        for (int ai = 0; ai < 2; ++ai)
#pragma unroll
            for (int m = 0; m < 4; ++m) { const int p = p0 + ai * 128 + m * 16;
                if (p < u.x2) { const int id = list[(size_t)u.x0 * T + p]; const float s = wts[id]; bf16_t* rowp = o2 + (size_t)id * 1024 + col0;
#pragma unroll
                    for (int bj = 0; bj < 2; ++bj) { const f32x4 v0 = acc[ai][bj][m][0] * s, v1 = acc[ai][bj][m][1] * s;
                        u32x4 ww; ww.x = cvt_pk_bf16(v0[0], v0[1]); ww.y = cvt_pk_bf16(v0[2], v0[3]); ww.z = cvt_pk_bf16(v1[0], v1[1]); ww.w = cvt_pk_bf16(v1[2], v1[3]);
                        *(u32x4*)(rowp + bj * 128) = ww; } }
                asm volatile("" ::: "memory"); }
    }
};

constexpr int GRID = 256;
template <int nN>
struct DenseOrder {
    const bf16_t* A; const bf16_t* Bt; int c;
    DI bool next(int i, Unit& u) const { int pm, pn; if (!pg8::static_tile<T / 256, nN, GRID>(i, c, pm, pn)) return false; u.pm = pm; u.pn = pn; u.A = A; u.Bt = Bt; u.x0 = 0; u.x1 = 0; u.x2 = 0; return true; }
};
struct BranchOrder {
    const bf16_t* A0; const bf16_t* A1; const bf16_t* B0; const bf16_t* B1; int c;
    DI bool next(int i, Unit& u) const { int pm, pn; if (!pg8::static_tile<T / 256, D / 256, GRID>(i >> 1, c, pm, pn)) return false;
        u.pm = pm; u.pn = pn; u.x0 = i & 1; u.A = (i & 1) ? A1 : A0; u.Bt = (i & 1) ? B1 : B0; u.x1 = 0; u.x2 = 0; return true; }
};
struct MoeOrder {
    const bf16_t* A; const bf16_t* Bt; size_t bstride; const unsigned* cnt; int c;
    DI bool next(int i, Unit& u) const {
        const int idx = i * GRID + c, rt = idx >> 2; int acc = 0, e = -1, jt = 0, ce = 0;
#pragma unroll
        for (int k = 0; k < NEXP; ++k) { const int n = (int)__builtin_amdgcn_readfirstlane(__hip_atomic_load(cnt + k, RLX_AGENT)); const int ntile = (n + 255) >> 8;
            if (e < 0 && rt < acc + ntile) { e = k; jt = rt - acc; ce = n; } acc += ntile; }
        if (e < 0) return false;
        u.pm = rt; u.pn = idx & 3; u.A = A; u.Bt = Bt + (size_t)e * bstride; u.x0 = e; u.x1 = jt; u.x2 = ce; return true;
    }
};

#define XB_TMO      128
#define XB_XCNT(j)  (256  + 64 * (j))
#define XB_XSUB(j)  (1280 + 64 * (j))
#define XB_XGEN(j)  (2304 + 64 * (j))
#define XB_TOP      3328
#define XB_TOPGEN   3392
#define XCD_BAR_WORDS 3456
#define XB_SPIN_CAP (1u << 22)
DI unsigned xb_ld(unsigned* p)              { return __hip_atomic_load(p, __ATOMIC_RELAXED, __HIP_MEMORY_SCOPE_AGENT); }
DI unsigned xb_add(unsigned* p, unsigned v) { return __hip_atomic_fetch_add(p, v, __ATOMIC_RELAXED, __HIP_MEMORY_SCOPE_AGENT); }
DI unsigned xb_xcc_id() { return (unsigned)__builtin_amdgcn_s_getreg((3 << 11) | 20) & 0xFu; }
#define XB_SPIN(cond, bar) do { unsigned _sp = 0; while (cond) { __builtin_amdgcn_s_sleep(1); \
    if ((++_sp & 255u) == 0u) { if (xb_ld(&(bar)[XB_TMO])) break; if (_sp > XB_SPIN_CAP) { atomicAdd(&(bar)[XB_TMO], 1u); break; } } } } while (0)
struct XcdBarrier { unsigned* bar; unsigned x; volatile LAS unsigned* st; };
DI XcdBarrier xcd_barrier_post(unsigned* bar, volatile LAS unsigned* st) {
    XcdBarrier b; b.bar = bar; b.x = xb_xcc_id(); b.st = st;
    if (threadIdx.x == 0) (void)xb_add(&bar[XB_XCNT(b.x)], 1u);
    return b;
}
DI void xcd_barrier_complete(unsigned* bar, unsigned x, unsigned& nloc, unsigned& nx) {
    const unsigned G = gridDim.x * gridDim.y * gridDim.z;
    unsigned sum, cnt, mine, sp = 0u;
    for (;;) {
        sum = 0u; cnt = 0u; mine = 0u;
#pragma unroll
        for (unsigned j = 0; j < 16; ++j) { const unsigned c = xb_ld(&bar[XB_XCNT(j)]); sum += c; cnt += (c > 0u) ? 1u : 0u; mine = (j == x) ? c : mine; }
        if (sum == G) break;
        __builtin_amdgcn_s_sleep(1);
        if ((++sp & 255u) == 0u) { if (xb_ld(&bar[XB_TMO])) break; if (sp > XB_SPIN_CAP) { atomicAdd(&bar[XB_TMO], 1u); break; } }
    }
    nloc = mine > 0u ? mine : 1u; nx = cnt > 0u ? cnt : 1u;
}
DI void xcd_barrier(const XcdBarrier& b, const bool leader) {
    asm volatile("s_waitcnt vmcnt(0)" ::: "memory");
    __syncthreads();
    if (leader) {
        unsigned* bar = b.bar;
        __builtin_amdgcn_s_waitcnt(0);
        unsigned nloc = b.st[0], nx = b.st[1];
        if (nloc == 0u) { xcd_barrier_complete(bar, b.x, nloc, nx); b.st[0] = nloc; b.st[1] = nx; }
        const unsigned old = xb_add(&bar[XB_XSUB(b.x)], 1u);
        const unsigned gen = old / nloc;
        if (old + 1u == (gen + 1u) * nloc) {
            __builtin_amdgcn_fence(__ATOMIC_RELEASE, "agent");
            asm volatile("s_waitcnt vmcnt(0)" ::: "memory");
            const unsigned og = xb_add(&bar[XB_TOP], 1u);
            const unsigned tg = og / nx;
            if (og + 1u == (tg + 1u) * nx) xb_add(&bar[XB_TOPGEN], 1u);
            else XB_SPIN(xb_ld(&bar[XB_TOPGEN]) == tg, bar);
            __builtin_amdgcn_fence(__ATOMIC_ACQUIRE, "agent");
            xb_add(&bar[XB_XGEN(b.x)], 1u);
            asm volatile("s_waitcnt vmcnt(0)" ::: "memory");
        } else {
            XB_SPIN(xb_ld(&bar[XB_XGEN(b.x)]) == gen, bar);
            __builtin_amdgcn_fence(__ATOMIC_ACQUIRE, "agent");
            asm volatile("s_waitcnt vmcnt(0)" ::: "memory");
        }
    }
    __syncthreads();
}

struct Frame {
    LAS unsigned char* lds;
    int tid, lane, wave, vcu, G;
    const float* const* in;
    float* out; unsigned char* ws;
};
enum { I_X = 0, I_C, I_POS, I_WADA, I_BADA, I_N1G, I_WIN, I_CONVW, I_CONVB, I_MIGB, I_MFGB, I_MNG, I_RNG, I_WBM, I_WBR, I_WOUT, I_N2G, I_WR1, I_BR1, I_WR2, I_BR2, I_WGATE, I_WUP, I_WDOWN, I_FG, N_IN };

struct Args { const float* in[N_IN]; float* out; unsigned char* ws; int ph_lo, ph_hi; };

DI void mods_phase(const Frame& F, const float* c, const float* w_ada, const float* b_ada, float* mod) {
    LAS float* sc = (LAS float*)F.lds;
    LAS float* red = (LAS float*)(F.lds + 32768);
    for (int i = F.tid; i < 8 * 1024; i += NTHR) sc[i] = siluf_(c[i]);
    __syncthreads();
    for (int it = F.vcu; it < 256; it += F.G) {
        const int l = it >> 7, cb = it & 127;
        const int c4 = F.tid % 12, ks = F.tid / 12;
        if (ks < 42) {
            f32x4 acc[8];
#pragma unroll
            for (int b = 0; b < 8; ++b) acc[b] = (f32x4){0.f, 0.f, 0.f, 0.f};
            for (int k = ks; k < 1024; k += 42) {
                const f32x4 w = *(const f32x4*)(w_ada + ((size_t)l * 1024 + k) * 6144 + 48 * cb + 4 * c4);
#pragma unroll
                for (int b = 0; b < 8; ++b) acc[b] += w * sc[b * 1024 + k];
            }
#pragma unroll
            for (int b = 0; b < 8; ++b) *(LAS f32x4*)(red + (ks * 8 + b) * 48 + 4 * c4) = acc[b];
        }
        __syncthreads();
        if (F.tid < 384) { const int b = F.tid / 48, col = F.tid % 48; float s = 0.f;
            for (int k = 0; k < 42; ++k) s += red[(k * 8 + b) * 48 + col];
            mod[((size_t)l * 8 + b) * 6144 + 48 * cb + col] = s + b_ada[l * 6144 + 48 * cb + col]; }
        __syncthreads();
    }
}
DI void rope_phase(const Frame& F, const int* pos, float* rope) {
    const int gt = F.vcu * NTHR + F.tid, NGT = F.G * NTHR;
    for (int i = gt; i < T * 64; i += NGT) {
        const int t = i >> 6, j = i & 63;
        const double inv = exp2(-(double)j * (13.287712379549449 / 64.0));
        const double ang = (double)pos[t] * inv;
        double r = ang * 0.15915494309189535; r -= rint(r);
        const double q = rint(r * 4.0); const double th = (r - q * 0.25) * 6.283185307179586; const int qi = ((int)q) & 3;
        const double t2 = th * th;
        const double s = th * (1.0 + t2 * (-1.0 / 6 + t2 * (1.0 / 120 + t2 * (-1.0 / 5040 + t2 * (1.0 / 362880 + t2 * (-1.0 / 39916800 + t2 * (1.0 / 6227020800.0)))))));
        const double cc = 1.0 + t2 * (-0.5 + t2 * (1.0 / 24 + t2 * (-1.0 / 720 + t2 * (1.0 / 40320 + t2 * (-1.0 / 3628800 + t2 * (1.0 / 479001600.0 + t2 * (-1.0 / 87178291200.0)))))));
        const double cs = qi == 0 ? cc : qi == 1 ? -s : qi == 2 ? -cc : s;
        const double sn = qi == 0 ? s : qi == 1 ? cc : qi == 2 ? -s : -cc;
        rope[(size_t)t * 128 + j] = (float)cs; rope[(size_t)t * 128 + 64 + j] = (float)sn;
    }
}
template <class Src>
DI void transpose_item(const Src& src, bf16_t* dst, int Kdst, LAS float* scr, int lane) {
#pragma unroll
    for (int hf = 0; hf < 2; ++hf) { float v[16];
#pragma unroll
        for (int i = 0; i < 16; ++i) v[i] = src(2 * (16 * hf + i) + (lane >> 5), lane & 31);
#pragma unroll
        for (int i = 0; i < 16; ++i) scr[(2 * (16 * hf + i) + (lane >> 5)) * 33 + (lane & 31)] = v[i];
        asm volatile("" ::: "memory"); }
    LDS_WAIT(); asm volatile("" ::: "memory");
    const int c = lane & 7;
#pragma unroll
    for (int j = 0; j < 4; ++j) { const int n = (lane >> 3) + 8 * j; const LAS float* s = scr + (8 * c) * 33 + n;
        u32x4 o; o.x = cvt_pk_bf16(s[0 * 33], s[1 * 33]); o.y = cvt_pk_bf16(s[2 * 33], s[3 * 33]); o.z = cvt_pk_bf16(s[4 * 33], s[5 * 33]); o.w = cvt_pk_bf16(s[6 * 33], s[7 * 33]);
        *(u32x4*)(dst + (size_t)n * Kdst + 8 * c) = o; }
    LDS_WAIT(); asm volatile("" ::: "memory");
}
DI void convert_weights(const Frame& F, int l, int part) {
    LAS float* scr = (LAS float*)(F.lds + 65536 + F.wave * 8448);
    const int gw = F.vcu * NWAVES + F.wave, NGW = F.G * NWAVES;
    const float* w_in = F.in[I_WIN] + (size_t)l * 1024 * DIN;
    const float* w_bm = F.in[I_WBM] + (size_t)l * 1024 * 1024; const float* w_br = F.in[I_WBR] + (size_t)l * 1024 * 1024; const float* w_out = F.in[I_WOUT] + (size_t)l * 1024 * 1024;
    const float* mng = F.in[I_MNG] + l * 1024; const float* rng = F.in[I_RNG] + l * 1024;
    const float* w_gate = F.in[I_WGATE] + (size_t)l * NEXP * 1024 * DFF; const float* w_up = F.in[I_WUP] + (size_t)l * NEXP * 1024 * DFF; const float* w_down = F.in[I_WDOWN] + (size_t)l * NEXP * DFF * 1024;
    bf16_t* t_in = (bf16_t*)(F.ws + WT_IN); bf16_t* t_bm = (bf16_t*)(F.ws + WT_BM); bf16_t* t_br = (bf16_t*)(F.ws + WT_BR); bf16_t* t_out = (bf16_t*)(F.ws + WT_OUT);
    bf16_t* t_gu = (bf16_t*)(F.ws + WT_GU); bf16_t* t_dn = (bf16_t*)(F.ws + WT_DN);
    constexpr int I_A = 16 * 256, I_B = 16 * 32, I_C = NEXP * 16 * 32, I_D = NEXP * 8 * 32;
    const int it_lo = part == 0 ? 0 : I_A + 3 * I_B, it_hi = part == 0 ? I_A + 3 * I_B : I_A + 3 * I_B + I_C + I_D;
    for (int it = it_lo + gw; it < it_hi; it += NGW) {
        int lane = F.lane; asm volatile("" : "+v"(lane));
        int r = it;
        if (r < I_A) { const int kb = r >> 8, nb = r & 255, k0 = 64 * kb, n0 = 32 * nb; const int sc0 = n0 + (n0 >= 3072 ? 8 : 0);
            const float* s = w_in + (size_t)k0 * DIN + sc0;
            transpose_item([&](int kk, int n) { return s[(size_t)kk * DIN + n]; }, t_in + (size_t)n0 * 1024 + k0, 1024, scr, lane); continue; }
        r -= I_A;
        if (r < 3 * I_B) { const int which = r / I_B, q = r % I_B, kb = q >> 5, nb = q & 31, k0 = 64 * kb, n0 = 32 * nb;
            const float* W = which == 0 ? w_bm : which == 1 ? w_br : w_out; bf16_t* Dst = which == 0 ? t_bm : which == 1 ? t_br : t_out;
            const float* g = which == 0 ? mng : rng; const bool sc = which < 2;
            const float* s = W + (size_t)k0 * 1024 + n0;
            transpose_item([&](int kk, int n) { const float v = s[(size_t)kk * 1024 + n]; return sc ? v * g[k0 + kk] : v; }, Dst + (size_t)n0 * 1024 + k0, 1024, scr, lane); continue; }
        r -= 3 * I_B;
        if (r < I_C) { const int e = r >> 9, q = r & 511, kb = q >> 5, qb = q & 31, k0 = 64 * kb;
            const float* sg = w_gate + ((size_t)e * 1024 + k0) * DFF + 16 * qb; const float* su = w_up + ((size_t)e * 1024 + k0) * DFF + 16 * qb;
            const long long dgu = su - sg;
            transpose_item([&](int kk, int n) { return sg[(size_t)kk * DFF + (n & 15) + (n < 16 ? 0ll : dgu)]; }, t_gu + ((size_t)e * 1024 + 32 * qb) * 1024 + k0, 1024, scr, lane); continue; }
        r -= I_C;
        { const int e = r >> 8, q = r & 255, kb = q >> 5, nb = q & 31, k0 = 64 * kb, n0 = 32 * nb;
            const float* s = w_down + ((size_t)e * DFF + k0) * 1024 + n0;
            transpose_item([&](int kk, int n) { return s[(size_t)kk * 1024 + n]; }, t_dn + ((size_t)e * 1024 + n0) * DFF + k0, DFF, scr, lane); }
    }
}

DI void rp1_phase(const Frame& F, int l) {
    LAS float* wg = (LAS float*)F.lds;
    const float* w_in = F.in[I_WIN] + (size_t)l * 1024 * DIN;
    for (int i = F.tid; i < 2048; i += NTHR) { const int k = i >> 1, hf = i & 1; *(LAS f32x4*)(wg + k * 8 + 4 * hf) = *(const f32x4*)(w_in + (size_t)k * DIN + 3072 + 4 * hf); }
    __syncthreads();
    const float* mod = (const float*)(F.ws + WS_MOD);
    const float* xin = l == 0 ? F.in[I_X] : F.out;
    const bf16_t* o2 = (const bf16_t*)(F.ws + WS_O2);
    bf16_t* H = (bf16_t*)(F.ws + WS_H); float* gates = (float*)(F.ws + WS_GATES);
    const int rows_per_wg = T / F.G, rpw = rows_per_wg / NWAVES, lane = F.lane;
    const int row0 = F.vcu * rows_per_wg + F.wave * rpw, b = row0 / SEQ;
    const float* m = mod + ((size_t)l * 8 + b) * 6144;
    f32x4 gm[4], sh[4], g2[4];
#pragma unroll
    for (int j = 0; j < 4; ++j) { const int c = 4 * lane + 256 * j; const f32x4 g = *(const f32x4*)(F.in[I_N1G] + l * 1024 + c); const f32x4 s1 = *(const f32x4*)(m + 1024 + c);
        gm[j] = g * (s1 + 1.0f); sh[j] = *(const f32x4*)(m + c);
        g2[j] = l > 0 ? *(const f32x4*)(mod + ((size_t)(l - 1) * 8 + b) * 6144 + 5 * 1024 + c) : (f32x4){0.f, 0.f, 0.f, 0.f}; }
    const float bias = lane < 4 ? F.in[I_MIGB][l * 4 + (lane & 3)] : F.in[I_MFGB][l * 4 + (lane & 3)];
    f32x4 xn[4]; u32x2 an[4], bn[4];
#pragma unroll
    for (int j = 0; j < 4; ++j) { xn[j] = *(const f32x4*)(xin + (size_t)row0 * 1024 + 4 * lane + 256 * j); an[j] = (u32x2){0u, 0u}; bn[j] = (u32x2){0u, 0u};
        if (l > 0) { an[j] = *(const u32x2*)(o2 + ((size_t)row0 * 2) * 1024 + 4 * lane + 256 * j); bn[j] = *(const u32x2*)(o2 + ((size_t)row0 * 2 + 1) * 1024 + 4 * lane + 256 * j); } }
    for (int i = 0; i < rpw; ++i) {
        const int row = row0 + i;
        f32x4 x[4]; u32x2 ac[4], bc[4];
#pragma unroll
        for (int j = 0; j < 4; ++j) { x[j] = xn[j]; ac[j] = an[j]; bc[j] = bn[j]; }
        if (i + 1 < rpw) {
#pragma unroll
            for (int j = 0; j < 4; ++j) { xn[j] = *(const f32x4*)(xin + (size_t)(row + 1) * 1024 + 4 * lane + 256 * j);
                if (l > 0) { an[j] = *(const u32x2*)(o2 + ((size_t)(row + 1) * 2) * 1024 + 4 * lane + 256 * j); bn[j] = *(const u32x2*)(o2 + ((size_t)(row + 1) * 2 + 1) * 1024 + 4 * lane + 256 * j); } }
        }
        if (l > 0) {
#pragma unroll
            for (int j = 0; j < 4; ++j) { const u32x2 a = ac[j], bb = bc[j];
                f32x4 o; o[0] = bf_lo(a.x) + bf_lo(bb.x); o[1] = bf_hi(a.x) + bf_hi(bb.x); o[2] = bf_lo(a.y) + bf_lo(bb.y); o[3] = bf_hi(a.y) + bf_hi(bb.y);
                if (DBG_NO_MOE) o = o * 0.f;
                x[j] += g2[j] * o; *(f32x4*)(F.out + (size_t)row * 1024 + 4 * lane + 256 * j) = x[j]; }
        }
        float ss = 0.f;
#pragma unroll
        for (int j = 0; j < 4; ++j) ss += (x[j][0] * x[j][0] + x[j][1] * x[j][1]) + (x[j][2] * x[j][2] + x[j][3] * x[j][3]);
        const float rstd = 1.0f / sqrtf(wave_sum(ss) * (1.0f / 1024.0f) + EPS);
        float p[8];
#pragma unroll
        for (int q = 0; q < 8; ++q) p[q] = 0.f;
#pragma unroll
        for (int j = 0; j < 4; ++j) { const f32x4 hv = x[j] * rstd * gm[j] + sh[j];
            u32x2 w; w.x = cvt_pk_bf16(hv[0], hv[1]); w.y = cvt_pk_bf16(hv[2], hv[3]);
            *(u32x2*)(H + (size_t)row * 1024 + 4 * lane + 256 * j) = w;
#pragma unroll
            for (int e = 0; e < 4; ++e) { const int k = 4 * lane + 256 * j + e; const f32x4 w0 = *(const LAS f32x4*)(wg + k * 8), w1 = *(const LAS f32x4*)(wg + k * 8 + 4);
                p[0] += hv[e] * w0[0]; p[1] += hv[e] * w0[1]; p[2] += hv[e] * w0[2]; p[3] += hv[e] * w0[3];
                p[4] += hv[e] * w1[0]; p[5] += hv[e] * w1[1]; p[6] += hv[e] * w1[2]; p[7] += hv[e] * w1[3]; }
            asm volatile("" ::: "memory"); }
#pragma unroll
        for (int q = 0; q < 8; ++q) p[q] = wave_sum(p[q]);
        const float mine = lane == 0 ? p[0] : lane == 1 ? p[1] : lane == 2 ? p[2] : lane == 3 ? p[3] : lane == 4 ? p[4] : lane == 5 ? p[5] : lane == 6 ? p[6] : p[7];
        if (lane < 8) gates[(size_t)row * 8 + lane] = mine + bias;
    }
}
DI void norm_phase(const Frame& F, bool dummy = false) {
    bf16_t* P = (bf16_t*)(F.ws + WS_PROJ);
    const int gw = F.vcu * NWAVES + F.wave, NGW = F.G * NWAVES, lane = F.lane;
    for (int it = gw; it < 2 * T; it += NGW) {
        const int row = it >> 1, br = it & 1;
        bf16_t* v = P + (size_t)(br ? PH_RV : PH_MV) * ((size_t)T * 1024) + (size_t)row * 1024 + 4 * lane;
        const bf16_t* g = P + (size_t)(br ? PH_RG : PH_MO) * ((size_t)T * 1024) + (size_t)row * 1024 + 4 * lane;
        u32x2 a[4], gg[4];
#pragma unroll
        for (int j = 0; j < 4; ++j) { a[j] = *(const u32x2*)(v + 256 * j); gg[j] = *(const u32x2*)(g + 256 * j); }
#pragma unroll
        for (int j = 0; j < 4; ++j) { const float x0 = bf_lo(a[j].x), x1 = bf_hi(a[j].x), x2 = bf_lo(a[j].y), x3 = bf_hi(a[j].y);
            const float ss = wave_sum((x0 * x0 + x1 * x1) + (x2 * x2 + x3 * x3));
            const float rstd = 1.0f / sqrtf(ss * (1.0f / 256.0f) + EPS);
            u32x2 w; w.x = cvt_pk_bf16(x0 * rstd * bf_lo(gg[j].x), x1 * rstd * bf_hi(gg[j].x)); w.y = cvt_pk_bf16(x2 * rstd * bf_lo(gg[j].y), x3 * rstd * bf_hi(gg[j].y));
            *(u32x2*)((dummy ? (bf16_t*)F.out + (size_t)br * ((size_t)T * 1024) + (size_t)row * 1024 + 4 * lane : v) + 256 * j) = w; }
    }
}
DI void rp2_phase(const Frame& F, int l, bool dummy = false) {
    LAS float* wr = (LAS float*)F.lds;
    LAS int* ent = (LAS int*)(F.lds + 81920);
    LAS int* cnts = (LAS int*)(F.lds + 81920 + 1024);
    const float* w_r1 = F.in[I_WR1] + (size_t)l * 1024 * 4; const float* w_r2 = F.in[I_WR2] + (size_t)l * 1024 * 16;
    for (int i = F.tid; i < 1024 * 5; i += NTHR) { const int k = i / 5, q = i % 5;
        const f32x4 v = q == 0 ? *(const f32x4*)(w_r1 + k * 4) : *(const f32x4*)(w_r2 + k * 16 + 4 * (q - 1));
        const int kp = (((k >> 8) * 4 + (k & 3)) * 64 + ((k & 255) >> 2));
        *(LAS f32x4*)(wr + kp * 20 + 4 * q) = v; }
    __syncthreads();
    const float* mod = (const float*)(F.ws + WS_MOD);
    bf16_t* H = (bf16_t*)(F.ws + WS_H); float* wts = (float*)(F.ws + WS_WTS); int* list = dummy ? (int*)(F.ws + WS_O2) : (int*)(F.ws + WS_LIST);
    unsigned* gcnt = (unsigned*)(F.ws + WS_CTL) + CW_CNT + 64 * (dummy ? 2 + l : l);
    const int rows_per_wg = T / F.G, rpw = rows_per_wg / NWAVES, lane = F.lane;
    const int rbase = F.vcu * rows_per_wg, row0 = rbase + F.wave * rpw, b = row0 / SEQ;
    const float* m = mod + ((size_t)l * 8 + b) * 6144;
    f32x4 gm[4], sh[4];
#pragma unroll
    for (int j = 0; j < 4; ++j) { const int c = 4 * lane + 256 * j; const f32x4 g = *(const f32x4*)(F.in[I_N2G] + l * 1024 + c); const f32x4 s2 = *(const f32x4*)(m + 4 * 1024 + c);
        gm[j] = g * (s2 + 1.0f); sh[j] = *(const f32x4*)(m + 3 * 1024 + c); }
    LAS float* bias = (LAS float*)(F.lds + 81920 + 2048);
    if (F.tid < 4) bias[F.tid] = F.in[I_BR1][l * 4 + F.tid]; else if (F.tid < 20) bias[F.tid] = F.in[I_BR2][l * 16 + F.tid - 4];
    __syncthreads();
    f32x4 xn[4];
#pragma unroll
    for (int j = 0; j < 4; ++j) xn[j] = *(const f32x4*)(F.out + (size_t)row0 * 1024 + 4 * lane + 256 * j);
    for (int i = 0; i < rpw; ++i) {
        const int row = row0 + i;
        f32x4 x[4];
#pragma unroll
        for (int j = 0; j < 4; ++j) x[j] = xn[j];
        if (i + 1 < rpw) {
#pragma unroll
            for (int j = 0; j < 4; ++j) xn[j] = *(const f32x4*)(F.out + (size_t)(row + 1) * 1024 + 4 * lane + 256 * j);
        }
        float ss = 0.f;
#pragma unroll
        for (int j = 0; j < 4; ++j) ss += (x[j][0] * x[j][0] + x[j][1] * x[j][1]) + (x[j][2] * x[j][2] + x[j][3] * x[j][3]);
        const float rstd = 1.0f / sqrtf(wave_sum(ss) * (1.0f / 1024.0f) + EPS);
        float p[20];
#pragma unroll
        for (int q = 0; q < 20; ++q) p[q] = 0.f;
#pragma unroll
        for (int j = 0; j < 4; ++j) { const f32x4 hv = x[j] * rstd * gm[j] + sh[j];
            u32x2 w; w.x = cvt_pk_bf16(hv[0], hv[1]); w.y = cvt_pk_bf16(hv[2], hv[3]);
            *(u32x2*)(H + (size_t)row * 1024 + 4 * lane + 256 * j) = w;
#pragma unroll
            for (int e = 0; e < 4; ++e) {
#pragma unroll
                for (int q = 0; q < 5; ++q) { const f32x4 wv = *(const LAS f32x4*)(wr + ((j * 4 + e) * 64 + lane) * 20 + 4 * q);
                    p[4 * q] += hv[e] * wv[0]; p[4 * q + 1] += hv[e] * wv[1]; p[4 * q + 2] += hv[e] * wv[2]; p[4 * q + 3] += hv[e] * wv[3]; }
                asm volatile("" ::: "memory"); } }
#pragma unroll
        for (int q = 0; q < 20; ++q) p[q] = wave_sum(p[q]);
        float l1[4];
#pragma unroll
        for (int q = 0; q < 4; ++q) l1[q] = p[q] + bias[q];
        int gt = 0; float mx = l1[0];
#pragma unroll
        for (int q = 1; q < 4; ++q) if (l1[q] > mx) { mx = l1[q]; gt = q; }
        float se = 0.f;
#pragma unroll
        for (int q = 0; q < 4; ++q) se += expf_(l1[q] - mx);
        const float pg = 1.0f / se;
        float l2[4];
#pragma unroll
        for (int q = 0; q < 4; ++q) l2[q] = (gt == 0 ? p[4 + q] : gt == 1 ? p[8 + q] : gt == 2 ? p[12 + q] : p[16 + q]) + bias[4 + 4 * gt + q];
        int i0 = 0; float v0 = l2[0];
#pragma unroll
        for (int q = 1; q < 4; ++q) if (l2[q] > v0) { v0 = l2[q]; i0 = q; }
        int i1 = -1; float v1 = -3.0e38f;
#pragma unroll
        for (int q = 0; q < 4; ++q) if (q != i0 && l2[q] > v1) { v1 = l2[q]; i1 = q; }
        const float e1 = expf_(v1 - v0), inv = 1.0f / (1.0f + e1);
        if (lane == 0) { wts[(size_t)row * 2] = inv * pg; wts[(size_t)row * 2 + 1] = e1 * inv * pg;
            ent[(row - rbase) * 2] = gt * 4 + i0; ent[(row - rbase) * 2 + 1] = gt * 4 + i1; }
    }
    __syncthreads();
    const int n2 = rows_per_wg * 2;
    int my_e = -1, rank = 0;
    if (F.tid < n2) { my_e = ent[F.tid];
        for (int e = 0; e < NEXP; ++e) { const unsigned long long mk = __ballot(my_e == e);
            if (my_e == e) rank = __popcll(mk & ((1ull << lane) - 1ull));
            if (lane == e) cnts[F.wave * 16 + e] = __popcll(mk); } }
    __syncthreads();
    if (F.tid < NEXP) { const int c0 = cnts[F.tid], c1 = cnts[16 + F.tid]; int base = 0;
        if (c0 + c1 > 0) base = (int)__hip_atomic_fetch_add(gcnt + F.tid, (unsigned)(c0 + c1), RLX_AGENT);
        cnts[32 + F.tid] = base; }
    __syncthreads();
    if (F.tid < n2) { const int pos = cnts[32 + my_e] + (F.wave ? cnts[my_e] : 0) + rank; list[(size_t)my_e * T + pos] = (rbase + (F.tid >> 1)) * 2 + (F.tid & 1); }
    __syncthreads();
}
DI void gather_phase(const Frame& F, int l) {
    unsigned* gcnt = (unsigned*)(F.ws + WS_CTL) + CW_CNT + 64 * l;
    const int* list = (const int*)(F.ws + WS_LIST); const bf16_t* H = (const bf16_t*)(F.ws + WS_H); bf16_t* HS = (bf16_t*)(F.ws + WS_HS);
    int cnt[NEXP];
#pragma unroll
    for (int k = 0; k < NEXP; ++k) cnt[k] = (int)__builtin_amdgcn_readfirstlane(__hip_atomic_load(gcnt + k, RLX_AGENT));
    const int gw = F.vcu * NWAVES + F.wave, NGW = F.G * NWAVES, lane = F.lane;
    for (int r = gw; r < 2 * T; r += NGW) {
        int acc = 0, tp = 0, e = 0, p = 0, slot = 0;
#pragma unroll
        for (int k = 0; k < NEXP; ++k) { if (r >= acc && r < acc + cnt[k]) { e = k; p = r - acc; slot = tp * 256 + p; } acc += cnt[k]; tp += (cnt[k] + 255) >> 8; }
        const int tok = list[(size_t)e * T + p] >> 1;
        const u32x4* src = (const u32x4*)(H + (size_t)tok * 1024); u32x4* dst = (u32x4*)(HS + (size_t)slot * 1024);
        const u32x4 a = src[lane], bq = src[64 + lane]; dst[lane] = a; dst[64 + lane] = bq;
    }
}
DI void final_phase(const Frame& F) {
    const float* mod = (const float*)(F.ws + WS_MOD); const bf16_t* o2 = (const bf16_t*)(F.ws + WS_O2);
    const int rows_per_wg = T / F.G, rpw = rows_per_wg / NWAVES, lane = F.lane;
    const int row0 = F.vcu * rows_per_wg + F.wave * rpw, b = row0 / SEQ;
    f32x4 g2[4], fg[4];
#pragma unroll
    for (int j = 0; j < 4; ++j) { const int c = 4 * lane + 256 * j; g2[j] = *(const f32x4*)(mod + ((size_t)8 + b) * 6144 + 5 * 1024 + c); fg[j] = *(const f32x4*)(F.in[I_FG] + c); }
    f32x4 xn[4]; u32x2 an[4], bn[4];
#pragma unroll
    for (int j = 0; j < 4; ++j) { xn[j] = *(const f32x4*)(F.out + (size_t)row0 * 1024 + 4 * lane + 256 * j);
        an[j] = *(const u32x2*)(o2 + ((size_t)row0 * 2) * 1024 + 4 * lane + 256 * j); bn[j] = *(const u32x2*)(o2 + ((size_t)row0 * 2 + 1) * 1024 + 4 * lane + 256 * j); }
    for (int i = 0; i < rpw; ++i) {
        const int row = row0 + i; f32x4 x[4]; u32x2 ac[4], bc[4];
#pragma unroll
        for (int j = 0; j < 4; ++j) { x[j] = xn[j]; ac[j] = an[j]; bc[j] = bn[j]; }
        if (i + 1 < rpw) {
#pragma unroll
            for (int j = 0; j < 4; ++j) { xn[j] = *(const f32x4*)(F.out + (size_t)(row + 1) * 1024 + 4 * lane + 256 * j);
                an[j] = *(const u32x2*)(o2 + ((size_t)(row + 1) * 2) * 1024 + 4 * lane + 256 * j); bn[j] = *(const u32x2*)(o2 + ((size_t)(row + 1) * 2 + 1) * 1024 + 4 * lane + 256 * j); }
        }
#pragma unroll
        for (int j = 0; j < 4; ++j) {
            const u32x2 a = ac[j], bb = bc[j];
            f32x4 o; o[0] = bf_lo(a.x) + bf_lo(bb.x); o[1] = bf_hi(a.x) + bf_hi(bb.x); o[2] = bf_lo(a.y) + bf_lo(bb.y); o[3] = bf_hi(a.y) + bf_hi(bb.y);
            if (DBG_NO_MOE) o = o * 0.f;
            x[j] += g2[j] * o; }
        float ss = 0.f;
#pragma unroll
        for (int j = 0; j < 4; ++j) ss += (x[j][0] * x[j][0] + x[j][1] * x[j][1]) + (x[j][2] * x[j][2] + x[j][3] * x[j][3]);
        const float rstd = 1.0f / sqrtf(wave_sum(ss) * (1.0f / 1024.0f) + EPS);
#pragma unroll
        for (int j = 0; j < 4; ++j) *(f32x4*)(F.out + (size_t)row * 1024 + 4 * lane + 256 * j) = x[j] * rstd * fg[j];
    }
}

namespace mix {
DI unsigned offb(unsigned row, unsigned ch) { return 256u * row + 16u * (ch ^ (((row & 3) << 2) | ((row >> 2) & 3))); }
DI bf16x8 ldrow(LAS unsigned char* lds, int base, int row, int ch) { return *(const LAS bf16x8*)(lds + base + offb(row, ch)); }
DI bf16x8 ldtr(LAS unsigned char* lds, int base, int c, int ks, int lane) {
    const unsigned g = lane >> 4, q = (lane & 15) >> 2, p = lane & 3;
    const unsigned a0 = base + offb(32 * ks + 8 * g + q, 2 * c + (p >> 1)) + 8 * (p & 1);
    const unsigned a1 = base + offb(32 * ks + 8 * g + 4 + q, 2 * c + (p >> 1)) + 8 * (p & 1);
    const s16x4 lo = __builtin_amdgcn_ds_read_tr16_b64_v4i16((LAS s16x4*)(lds + a0));
    const s16x4 hi = __builtin_amdgcn_ds_read_tr16_b64_v4i16((LAS s16x4*)(lds + a1));
    return __builtin_shufflevector(lo, hi, 0, 1, 2, 3, 4, 5, 6, 7);
}
#define MFMA16(a, b, c) __builtin_amdgcn_mfma_f32_16x16x32_bf16((a), (b), (c), 0, 0, 0)
constexpr float SCK = 0.08838834764831845f;
DI u32x4 pack8(const float (&y)[8]) { u32x4 o; o.x = cvt_pk_bf16(y[0], y[1]); o.y = cvt_pk_bf16(y[2], y[3]); o.z = cvt_pk_bf16(y[4], y[5]); o.w = cvt_pk_bf16(y[6], y[7]); return o; }
DI void unpack8(const u32x4 x, float (&a)[8]) { a[0] = bf_lo(x.x); a[1] = bf_hi(x.x); a[2] = bf_lo(x.y); a[3] = bf_hi(x.y); a[4] = bf_lo(x.z); a[5] = bf_hi(x.z); a[6] = bf_lo(x.w); a[7] = bf_hi(x.w); }
DI void load8f(const float* p, float (&a)[8]) { const f32x4 u = *(const f32x4*)p, v = *(const f32x4*)(p + 4); a[0] = u[0]; a[1] = u[1]; a[2] = u[2]; a[3] = u[3]; a[4] = v[0]; a[5] = v[1]; a[6] = v[2]; a[7] = v[3]; }

DI void ms_phase(const Frame& F, int l, unsigned long long& pr_acc) {
#define SUBP(id, stmt) do { unsigned long long t0_ = 0; if (DBG_PROBE == (id)) t0_ = __builtin_amdgcn_s_memrealtime(); stmt; if (DBG_PROBE == (id)) pr_acc += __builtin_amdgcn_s_memrealtime() - t0_; } while (0)
    LAS unsigned char* lds = F.lds;
    LAS float* wvv = (LAS float*)(lds + 131072);
    LAS float* dec = (LAS float*)(lds + 139264);
    LAS float* npart = (LAS float*)(lds + 139264 + 256);
    int tid = F.tid, lane = F.lane, w = F.wave, fr = lane & 15, fq = lane >> 4;
    bf16_t* P = (bf16_t*)(F.ws + WS_PROJ);
    const float* gates = (const float*)(F.ws + WS_GATES); const float* rope = (const float*)(F.ws + WS_ROPE);
    for (int item = F.vcu; item < 256; item += F.G) {
        const int br = item >> 7, b = (item >> 4) & 7, h = (item >> 2) & 3, sl = item & 3;
        const bf16_t* kb = P + (size_t)(br ? PH_RQK : PH_MQK) * ((size_t)T * 1024) + 512 + h * 128;
        const bf16_t* vb = P + (size_t)(br ? PH_RV : PH_MV) * ((size_t)T * 1024) + h * 256 + sl * 64;
        float* TS = (float*)(F.ws + WS_TS) + (size_t)(b * 4 + h) * SEQ * 4;
        float* NG = (float*)(F.ws + WS_NG) + (size_t)(b * 4 + h) * 16 * 128;
        bf16_t* SG = (bf16_t*)(F.ws + WS_SG) + ((((size_t)br * 8 + b) * 4 + h) * 16) * 32768 + (size_t)sl * 64 * 128;
        if (br == 0) {
            LAS float* tb = (LAS float*)lds; LAS float* tg = tb + 2048; LAS float* tpm = tb + 4096; LAS float* ta = tb + 6144; LAS float* cs = tb + 8192;
#pragma unroll
            for (int cc = 0; cc < 2; ++cc) { const int c = 2 * w + cc; const size_t t = (size_t)b * SEQ + c * 128 + 2 * lane;
                const float i0 = gates[t * 8 + h], i1 = gates[(t + 1) * 8 + h], f0 = gates[t * 8 + 4 + h], f1 = gates[(t + 1) * 8 + 4 + h];
                const float lf0 = fminf(f0, 0.f) - log1pf(__expf(-fabsf(f0))), lf1 = fminf(f1, 0.f) - log1pf(__expf(-fabsf(f1)));
                float incl = lf0 + lf1;
#pragma unroll
                for (int o = 1; o < 64; o <<= 1) { const float tt = shfl_up_l(incl, o, lane); if (lane >= o) incl += tt; }
                const float b1 = incl, b0 = incl - lf1, btot = lane_get(incl, 63);
                const float a0 = btot - b0 + i0, a1 = btot - b1 + i1, amax = wave_max(fmaxf(a0, a1));
                const float g0 = i0 - b0, g1 = i1 - b1;
                float pm = fmaxf(g0, g1);
#pragma unroll
                for (int o = 1; o < 64; o <<= 1) { const float tt = shfl_up_l(pm, o, lane); if (lane >= o) pm = fmaxf(pm, tt); }
                const float pmprev = shfl_up_l(pm, 1, lane); const float pm0 = lane == 0 ? g0 : fmaxf(pmprev, g0), mu = lane_get(pm, 63);
                const int ix = c * 128 + 2 * lane;
                *(LAS f32x2*)(tb + ix) = (f32x2){b0, b1}; *(LAS f32x2*)(tg + ix) = (f32x2){g0, g1}; *(LAS f32x2*)(tpm + ix) = (f32x2){pm0, pm}; *(LAS f32x2*)(ta + ix) = (f32x2){a0, a1};
                if (lane == 0) { cs[c] = btot; cs[16 + c] = amax; cs[32 + c] = mu; } }
            __syncthreads();
            if (tid == 0) { float m = 0.f;
                for (int c = 0; c < 16; ++c) { const float mn = fmaxf(cs[c] + m, cs[16 + c]); dec[c] = __expf(cs[c] + m - mn); cs[48 + c] = m; cs[64 + c] = mn; m = mn; } }
            __syncthreads();
#pragma unroll
            for (int i = 0; i < 4; ++i) { const int t = tid + NTHR * i, c = t >> 7;
                wvv[t] = __expf(ta[t] - cs[64 + c]) * SCK;
                if (sl == 0) { const float mst = cs[48 + c], M = fmaxf(mst, tpm[t]), mu = cs[32 + c];
                    const f32x4 v = (f32x4){__expf(fminf(mu - M, 80.f)), __expf(tg[t] - mu) * SCK, __expf(mst - M), __expf(fminf(-(tb[t] + M), 80.f))};
                    *(f32x4*)(TS + (size_t)t * 4) = v; } }
        } else {
            const float lg = __logf(1.0f - exp2f(-5.0f - (float)h));
#pragma unroll
            for (int i = 0; i < 4; ++i) { const int t = tid + NTHR * i; wvv[t] = __expf(lg * (float)(127 - (t & 127))) * SCK; }
            if (tid < 16) dec[tid] = __expf(lg * 128.0f);
        }
        __syncthreads();
        const int kch = 512 + h * 128;
        float cw[4][8], cbv[8];
        if (br == 0) { const int cch = kch + 8 * (tid & 15);
#pragma unroll
            for (int j = 0; j < 4; ++j) load8f(F.in[I_CONVW] + ((size_t)l * 4 + j) * 1024 + cch, cw[j]);
            load8f(F.in[I_CONVB] + (size_t)l * 1024 + cch, cbv);
        } else {
#pragma unroll
            for (int j = 0; j < 4; ++j)
#pragma unroll
                for (int e = 0; e < 8; ++e) cw[j][e] = 0.f;
#pragma unroll
            for (int e = 0; e < 8; ++e) cbv[e] = 0.f;
        }
        f32x4 st[4];
#pragma unroll
        for (int c = 0; c < 4; ++c) st[c] = (f32x4){0.f, 0.f, 0.f, 0.f};
        float nreg = 0.f;
        u32x4 pre[12]; u32x4 vr[2];
#define MS_LOAD(CH) do { const int t0_ = b * SEQ + (CH) * 128; \
        if (br == 0) { const int rb_ = tid >> 4, cg_ = tid & 15; _Pragma("unroll") for (int i_ = 0; i_ < 7; ++i_) { const int rr_ = 4 * rb_ - 3 + i_; const bool ok_ = ((CH) > 0) || (rr_ >= 0); \
                const int rc_ = (t0_ + rr_) < 0 ? 0 : (t0_ + rr_); const u32x4 ld_ = *(const u32x4*)(kb + (size_t)rc_ * 1024 + 8 * cg_);     \
                pre[i_] = ok_ ? ld_ : (u32x4){0u, 0u, 0u, 0u}; } } \
        else { _Pragma("unroll") for (int it_ = 0; it_ < 2; ++it_) { const int pi_ = tid + NTHR * it_, r_ = pi_ >> 3, cg_ = pi_ & 7; const size_t tok_ = (size_t)(t0_ + r_); \
                pre[it_] = *(const u32x4*)(kb + tok_ * 1024 + 8 * cg_); pre[2 + it_] = *(const u32x4*)(kb + tok_ * 1024 + 64 + 8 * cg_); \
                pre[4 + it_] = *(const u32x4*)(rope + tok_ * 128 + 8 * cg_); pre[6 + it_] = *(const u32x4*)(rope + tok_ * 128 + 8 * cg_ + 4); \
                pre[8 + it_] = *(const u32x4*)(rope + tok_ * 128 + 64 + 8 * cg_); pre[10 + it_] = *(const u32x4*)(rope + tok_ * 128 + 64 + 8 * cg_ + 4); } } \
        _Pragma("unroll") for (int it_ = 0; it_ < 2; ++it_) { const int pi_ = tid + NTHR * it_, r_ = pi_ >> 3, cg_ = pi_ & 7; vr[it_] = *(const u32x4*)(vb + (size_t)(t0_ + r_) * 1024 + 8 * cg_); } } while (0)
#define MS_WRITE(CH, STG) do { const int kbase_ = (STG) * 65536, vbase_ = (STG) * 65536 + 32768; \
        if (br == 0) { const int rb_ = tid >> 4, cg_ = tid & 15; _Pragma("unroll") for (int r_ = 0; r_ < 4; ++r_) { float y_[8]; _Pragma("unroll") for (int e_ = 0; e_ < 8; ++e_) y_[e_] = cbv[e_]; \
                _Pragma("unroll") for (int j_ = 0; j_ < 4; ++j_) { float x_[8]; unpack8(pre[r_ + j_], x_); _Pragma("unroll") for (int e_ = 0; e_ < 8; ++e_) y_[e_] += cw[j_][e_] * x_[e_]; } \
                _Pragma("unroll") for (int e_ = 0; e_ < 8; ++e_) y_[e_] = siluf_(y_[e_]); \
                *(LAS u32x4*)(lds + kbase_ + offb(4 * rb_ + r_, cg_)) = pack8(y_); } } \
        else { _Pragma("unroll") for (int it_ = 0; it_ < 2; ++it_) { const int pi_ = tid + NTHR * it_, r_ = pi_ >> 3, cg_ = pi_ & 7; \
                float a_[8], d_[8], o1_[8], o2_[8]; unpack8(pre[it_], a_); unpack8(pre[2 + it_], d_); \
                const f32x4 c0_ = __builtin_bit_cast(f32x4, pre[4 + it_]), c1_ = __builtin_bit_cast(f32x4, pre[6 + it_]), s0_ = __builtin_bit_cast(f32x4, pre[8 + it_]), s1_ = __builtin_bit_cast(f32x4, pre[10 + it_]); \
                const float cs_[8] = {c0_[0], c0_[1], c0_[2], c0_[3], c1_[0], c1_[1], c1_[2], c1_[3]}; \
                const float sn_[8] = {s0_[0], s0_[1], s0_[2], s0_[3], s1_[0], s1_[1], s1_[2], s1_[3]}; \
                _Pragma("unroll") for (int e_ = 0; e_ < 8; ++e_) { o1_[e_] = a_[e_] * cs_[e_] - d_[e_] * sn_[e_]; o2_[e_] = a_[e_] * sn_[e_] + d_[e_] * cs_[e_]; } \
                *(LAS u32x4*)(lds + kbase_ + offb(r_, cg_)) = pack8(o1_); *(LAS u32x4*)(lds + kbase_ + offb(r_, 8 + cg_)) = pack8(o2_); } } \
        _Pragma("unroll") for (int it_ = 0; it_ < 2; ++it_) { const int pi_ = tid + NTHR * it_, r_ = pi_ >> 3, cg_ = pi_ & 7; const float wv_ = wvv[(CH) * 128 + r_]; \
            float x_[8]; unpack8(vr[it_], x_); _Pragma("unroll") for (int e_ = 0; e_ < 8; ++e_) x_[e_] *= wv_; *(LAS u32x4*)(lds + vbase_ + offb(r_, cg_)) = pack8(x_); } } while (0)
        MS_LOAD(0); MS_WRITE(0, 0);
        __syncthreads();
        unsigned pf = 0u;
        for (int ch = 0; ch < 16; ++ch) {
            { int l_ = lane_id(); asm volatile("" : "+v"(l_)); lane = l_; w = F.wave; tid = w * 64 + l_; fr = lane & 15; fq = lane >> 4; }
#pragma unroll
            for (int c = 0; c < 4; ++c) { u32x2 wv; wv.x = cvt_pk_bf16(st[c][0], st[c][1]); wv.y = cvt_pk_bf16(st[c][2], st[c][3]);
                *(u32x2*)(SG + (size_t)ch * 32768 + (size_t)(16 * c + fr) * 128 + 16 * w + 4 * fq) = wv; }
            if (br == 0 && sl == 0 && tid < 128) NG[ch * 128 + tid] = nreg;
            if (ch == 15) break;
            const bool more = ch + 1 < 15;
            SUBP(20, if (more) MS_LOAD(ch + 1));
            asm volatile("" :: "v"(pf));
            pf = 0u;
            if (ch + 2 < 15 && tid < 384) { const size_t t2 = (size_t)b * SEQ + (size_t)(ch + 2) * 128;
                pf = tid < 256 ? *(const unsigned*)(kb + (t2 + (tid >> 1)) * 1024 + 64 * (tid & 1)) : *(const unsigned*)(vb + (t2 + (tid - 256)) * 1024); }
            const int stg = ch & 1, kbase = stg * 65536, vbase = stg * 65536 + 32768;
            const float decay = dec[ch];
            unsigned long long t21 = 0; if (DBG_PROBE == 21) t21 = __builtin_amdgcn_s_memrealtime();
            { bf16x8 ak[4];
#pragma unroll
              for (int ks = 0; ks < 4; ++ks) ak[ks] = ldtr(lds, kbase, w, ks, lane);
#pragma unroll
              for (int c = 0; c < 4; ++c) { st[c] = st[c] * decay;
#pragma unroll
                  for (int ks = 0; ks < 4; ++ks) st[c] = MFMA16(ak[ks], ldtr(lds, vbase, c, ks, lane), st[c]); } }
            if (DBG_PROBE == 21) { asm volatile("" :: "v"(st[0]), "v"(st[1]), "v"(st[2]), "v"(st[3])); pr_acc += __builtin_amdgcn_s_memrealtime() - t21; }
            if (br == 0 && sl == 0) { const int d = tid & 127, sq = tid >> 7; float s = 0.f;
                for (int r = 0; r < 32; ++r) { const int srow = 32 * sq + r; const unsigned short kv = *(const LAS unsigned short*)(lds + kbase + offb(srow, d >> 3) + 2 * (d & 7));
                    s += wvv[ch * 128 + srow] * __uint_as_float(((unsigned)kv) << 16); }
                npart[(stg * 4 + sq) * 128 + d] = s; }
            SUBP(22, if (more) MS_WRITE(ch + 1, stg ^ 1));
            SUBP(23, __syncthreads());
            if (br == 0 && sl == 0 && tid < 128) nreg = decay * nreg + ((npart[(stg * 4) * 128 + tid] + npart[(stg * 4 + 1) * 128 + tid]) + (npart[(stg * 4 + 2) * 128 + tid] + npart[(stg * 4 + 3) * 128 + tid]));
        }
#undef MS_LOAD
#undef MS_WRITE
#undef SUBP
        __syncthreads();
    }
}

DI void m2_phase(const Frame& F, int l, unsigned long long& pr_acc) {
    constexpr int QS = 0, KS = 32768, VLO = 0, PS = 65536, SC = 98304;
    constexpr int F_ALPHA = 0, F_BETA = 128, F_IW = 256, F_EMT = 384, F_RSUM = 512  , F_QN = 1536  , F_NST = 2048, F_SSQ = 2176  ;
    LAS unsigned char* lds = F.lds; LAS float* sc = (LAS float*)(lds + SC);
    int tid = F.tid, lane = F.lane, w = F.wave, fr = lane & 15, fq = lane >> 4;
    bf16_t* P = (bf16_t*)(F.ws + WS_PROJ);
    const float* rope = (const float*)(F.ws + WS_ROPE);
    unsigned pf0 = 0u, pf1 = 0u, pf2 = 0u, pf3 = 0u;
    unsigned long long tl_ = 0;
#define STAMP(id) do { if (DBG_PROBE >= 30 && DBG_PROBE <= 34) { const unsigned long long n_ = __builtin_amdgcn_s_memrealtime(); if (DBG_PROBE == (id)) pr_acc += n_ - tl_; tl_ = n_; } } while (0)
    for (int i4 = 0; i4 < 4; ++i4) {
        STAMP(-1);
        { int l_ = lane_id(); asm volatile("" : "+v"(l_)); lane = l_; w = F.wave; tid = w * 64 + l_; fr = lane & 15; fq = lane >> 4; }
        const int br = i4 & 1, rest = (i4 >> 1) * 256 + F.vcu, b = rest >> 6, h = (rest >> 4) & 3, ch = rest & 15;
        const int t0 = b * SEQ + ch * 128;
        const bf16_t* qk = P + (size_t)(br ? PH_RQK : PH_MQK) * ((size_t)T * 1024);
        bf16_t* vt = P + (size_t)(br ? PH_RV : PH_MV) * ((size_t)T * 1024) + (size_t)t0 * 1024 + h * 256;
        const bf16_t* gt = P + (size_t)(br ? PH_RG : PH_MO) * ((size_t)T * 1024) + (size_t)t0 * 1024 + h * 256;
        const bf16_t* SG = (const bf16_t*)(F.ws + WS_SG) + ((((size_t)br * 8 + b) * 4 + h) * 16 + ch) * 32768;
        if (br == 0) {
            const int cm = tid >> 8, crb = (tid >> 4) & 15, ccg = tid & 15, cch = cm * 512 + h * 128 + 8 * ccg;
            u32x4 raw[11];
#pragma unroll
            for (int i = 0; i < 11; ++i) { const int rr = 8 * crb - 3 + i; const bool ok = (ch > 0) || (rr >= 0);
                const int rc = (t0 + rr) < 0 ? 0 : (t0 + rr); const u32x4 ld = *(const u32x4*)(qk + (size_t)rc * 1024 + cch);
                raw[i] = ok ? ld : (u32x4){0u, 0u, 0u, 0u}; }
            float cw[4][8], cbv[8];
#pragma unroll
            for (int j = 0; j < 4; ++j) load8f(F.in[I_CONVW] + ((size_t)l * 4 + j) * 1024 + cch, cw[j]);
            load8f(F.in[I_CONVB] + (size_t)l * 1024 + cch, cbv);
            if (tid < 128) { const f32x4 v = *(const f32x4*)((const float*)(F.ws + WS_TS) + ((size_t)(b * 4 + h) * SEQ + ch * 128 + tid) * 4);
                sc[F_ALPHA + tid] = v[0]; sc[F_BETA + tid] = v[1]; sc[F_IW + tid] = v[2]; sc[F_EMT + tid] = v[3];
                sc[F_NST + tid] = ((const float*)(F.ws + WS_NG))[((size_t)(b * 4 + h) * 16 + ch) * 128 + tid]; }
#pragma unroll
            for (int r = 0; r < 8; ++r) { float y[8];
#pragma unroll
                for (int e = 0; e < 8; ++e) y[e] = cbv[e];
#pragma unroll
                for (int j = 0; j < 4; ++j) { float x[8]; unpack8(raw[r + j], x);
#pragma unroll
                    for (int e = 0; e < 8; ++e) y[e] += cw[j][e] * x[e]; }
#pragma unroll
                for (int e = 0; e < 8; ++e) y[e] = siluf_(y[e]);
                *(LAS u32x4*)(lds + (cm ? KS : QS) + offb(8 * crb + r, ccg)) = pack8(y); }
        } else {
            if (tid < 128) { const float lg = __logf(1.0f - exp2f(-5.0f - (float)h));
                sc[F_ALPHA + tid] = __expf(lg * (float)tid); sc[F_BETA + tid] = __expf(-lg * (float)tid) * SCK; sc[F_IW + tid] = __expf(lg * (float)(tid + 1)); }
#pragma unroll
            for (int it = 0; it < 2; ++it) { const int pi = tid + NTHR * it, r = pi >> 3, cg = pi & 7; const size_t tok = (size_t)(t0 + r);
                float cs[8], sn[8]; load8f(rope + tok * 128 + 8 * cg, cs); load8f(rope + tok * 128 + 64 + 8 * cg, sn);
#pragma unroll
                for (int mq = 0; mq < 2; ++mq) { const bf16_t* src = qk + tok * 1024 + mq * 512 + h * 128 + 8 * cg;
                    float a[8], d[8], o1[8], o2[8]; unpack8(*(const u32x4*)src, a); unpack8(*(const u32x4*)(src + 64), d);
#pragma unroll
                    for (int e = 0; e < 8; ++e) { o1[e] = a[e] * cs[e] - d[e] * sn[e]; o2[e] = a[e] * sn[e] + d[e] * cs[e]; }
                    *(LAS u32x4*)(lds + (mq ? KS : QS) + offb(r, cg)) = pack8(o1); *(LAS u32x4*)(lds + (mq ? KS : QS) + offb(r, 8 + cg)) = pack8(o2); } }
        }
        asm volatile("" :: "v"(pf0), "v"(pf1), "v"(pf2), "v"(pf3));
        pf0 = 0u; pf1 = 0u; pf2 = 0u; pf3 = 0u;
        if (i4 + 1 < 4) { const int nbr = (i4 + 1) & 1, nrest = ((i4 + 1) >> 1) * 256 + F.vcu, nb = nrest >> 6, nh = (nrest >> 4) & 3, nch = nrest & 15; const size_t nt0 = (size_t)nb * SEQ + nch * 128;
            const size_t PB_ = (size_t)T * 1024; const size_t rowo = (nt0 + (tid >> 2)) * 1024;
            pf0 = *(const unsigned*)(P + (size_t)(nbr ? PH_RQK : PH_MQK) * PB_ + rowo + ((tid & 2) ? 512 : 0) + nh * 128 + 64 * (tid & 1));
            pf1 = *(const unsigned*)(P + (size_t)(nbr ? PH_RV : PH_MV) * PB_ + rowo + nh * 256 + 64 * (tid & 3));
            pf2 = *(const unsigned*)(P + (size_t)(nbr ? PH_RG : PH_MO) * PB_ + rowo + nh * 256 + 64 * (tid & 3));
            pf3 = *(const unsigned*)((const bf16_t*)(F.ws + WS_SG) + ((((size_t)nbr * 8 + nb) * 4 + nh) * 16 + nch) * 32768 + (size_t)tid * 64); }
        __syncthreads();
        STAMP(30);
        u32x4 vr[8];
#pragma unroll
        for (int i = 0; i < 8; ++i) { const int pi = tid + NTHR * i, r = pi >> 5, cg = pi & 31; vr[i] = *(const u32x4*)(vt + (size_t)r * 1024 + 8 * cg); }
        bf16x8 sf[2][4];
#pragma unroll
        for (int c2 = 0; c2 < 2; ++c2)
#pragma unroll
            for (int ks = 0; ks < 4; ++ks) sf[c2][ks] = *(const bf16x8*)(SG + (size_t)(32 * w + 16 * c2 + fr) * 128 + 32 * ks + 8 * fq);
        for (int tt = w; tt < 40; tt += NWAVES) {
            int ti = 0, tj = 0, acc0 = 0;
#pragma unroll
            for (int i = 0; i < 8; ++i) { const int n = i + 1 + ((i & 1) ^ 1); if (tt >= acc0 && tt < acc0 + n) { ti = i; tj = tt - acc0; } acc0 += n; }
            u32x2 pw = (u32x2){0u, 0u};
            if (tj <= ti) {
                f32x4 a4 = (f32x4){0.f, 0.f, 0.f, 0.f};
#pragma unroll
                for (int ks = 0; ks < 4; ++ks) a4 = MFMA16(ldrow(lds, KS, 16 * tj + fr, 4 * ks + fq), ldrow(lds, QS, 16 * ti + fr, 4 * ks + fq), a4);
                const float al = sc[F_ALPHA + 16 * ti + fr]; const f32x4 be = *(const LAS f32x4*)(sc + F_BETA + 16 * tj + 4 * fq);
                float p[4];
#pragma unroll
                for (int r = 0; r < 4; ++r) { const float v = a4[r] * al * be[r]; p[r] = (ti == tj && (4 * fq + r) > fr) ? 0.f : v; }
                float rs = (p[0] + p[1]) + (p[2] + p[3]); rs += shfl_xor_l(rs, 16, lane); rs += shfl_xor_l(rs, 32, lane);
                if (fq == 0) sc[F_RSUM + tj * 128 + 16 * ti + fr] = rs;
                pw.x = cvt_pk_bf16(p[0], p[1]); pw.y = cvt_pk_bf16(p[2], p[3]);
            }
            *(LAS u32x2*)(lds + PS + offb(16 * ti + fr, 2 * tj + (fq >> 1)) + 8 * (fq & 1)) = pw;
        }
        f32x4 acc[2][8];
#pragma unroll
        for (int c2 = 0; c2 < 2; ++c2)
#pragma unroll
            for (int j = 0; j < 8; ++j) acc[c2][j] = (f32x4){0.f, 0.f, 0.f, 0.f};
#pragma unroll
        for (int ks = 0; ks < 4; ++ks)
#pragma unroll
            for (int j = 0; j < 8; ++j) { const bf16x8 bq = ldrow(lds, QS, 16 * j + fr, 4 * ks + fq);
                acc[0][j] = MFMA16(sf[0][ks], bq, acc[0][j]); acc[1][j] = MFMA16(sf[1][ks], bq, acc[1][j]); }
        if (br == 0) { const int lrow = tid & 127, dq = tid >> 7; float s = 0.f;
#pragma unroll
            for (int c4 = 0; c4 < 4; ++c4) { const bf16x8 v = ldrow(lds, QS, lrow, 4 * dq + c4);
#pragma unroll
                for (int j = 0; j < 8; ++j) s += bf2f(v[j]) * sc[F_NST + 32 * dq + 8 * c4 + j]; }
            sc[F_QN + dq * 128 + lrow] = s; }
        __syncthreads();
        STAMP(31);
#pragma unroll
        for (int i = 0; i < 8; ++i) { const int pi = tid + NTHR * i, r = pi >> 5, cg = pi & 31; *(LAS u32x4*)(lds + VLO + (cg >> 4) * 32768 + offb(r, cg & 15)) = vr[i]; }
        u32x2 gg[2][8];
#pragma unroll
        for (int c2 = 0; c2 < 2; ++c2)
#pragma unroll
            for (int j = 0; j < 8; ++j) gg[c2][j] = *(const u32x2*)(gt + (size_t)(16 * j + fr) * 1024 + 32 * w + 16 * c2 + 4 * fq);
        __syncthreads();
        STAMP(32);
#pragma unroll
        for (int j = 0; j < 8; ++j) { const float iw = sc[F_IW + 16 * j + fr]; acc[0][j] = acc[0][j] * iw; acc[1][j] = acc[1][j] * iw; }
#pragma unroll
        for (int ks = 0; ks < 4; ++ks) {
            const bf16x8 a0 = ldtr(lds, VLO + ((2 * w) >> 3) * 32768, (2 * w) & 7, ks, lane), a1 = ldtr(lds, VLO + ((2 * w + 1) >> 3) * 32768, (2 * w + 1) & 7, ks, lane);
#pragma unroll
            for (int j = 0; j < 8; ++j) if (j >= 2 * ks) { const bf16x8 bp = ldrow(lds, PS, 16 * j + fr, 4 * ks + fq);
                acc[0][j] = MFMA16(a0, bp, acc[0][j]); acc[1][j] = MFMA16(a1, bp, acc[1][j]); }
        }
#pragma unroll
        for (int j = 0; j < 8; ++j) { const int lrow = 16 * j + fr; float scale = 1.0f;
            if (br == 0) { float den = 0.f;
#pragma unroll
                for (int jj = 0; jj < 8; ++jj) if (jj <= j) den += sc[F_RSUM + jj * 128 + lrow];
                den += sc[F_IW + lrow] * ((sc[F_QN + lrow] + sc[F_QN + 128 + lrow]) + (sc[F_QN + 256 + lrow] + sc[F_QN + 384 + lrow]));
                scale = 1.0f / fmaxf(fabsf(den), sc[F_EMT + lrow]); }
            acc[0][j] = acc[0][j] * scale; acc[1][j] = acc[1][j] * scale;
            float ss = 0.f;
#pragma unroll
            for (int r = 0; r < 4; ++r) ss += acc[0][j][r] * acc[0][j][r] + acc[1][j][r] * acc[1][j][r];
            ss += shfl_xor_l(ss, 16, lane); ss += shfl_xor_l(ss, 32, lane);
            if (fq == 0) sc[F_SSQ + w * 128 + lrow] = ss; }
        __syncthreads();
        STAMP(33);
#pragma unroll
        for (int j = 0; j < 8; ++j) { const int lrow = 16 * j + fr; float ss = 0.f;
#pragma unroll
            for (int ww = 0; ww < 8; ++ww) ss += sc[F_SSQ + ww * 128 + lrow];
            const float rstd = 1.0f / sqrtf(ss * (1.0f / 256.0f) + EPS);
#pragma unroll
            for (int c2 = 0; c2 < 2; ++c2) { const f32x4 o = acc[c2][j] * rstd; const u32x2 g = gg[c2][j];
                u32x2 wv; wv.x = cvt_pk_bf16(o[0] * bf_lo(g.x), o[1] * bf_hi(g.x)); wv.y = cvt_pk_bf16(o[2] * bf_lo(g.y), o[3] * bf_hi(g.y));
                *(u32x2*)(vt + (size_t)lrow * 1024 + 32 * w + 16 * c2 + 4 * fq) = wv; } }
        __syncthreads();
        STAMP(34);
    }
#undef STAMP
}
}

constexpr int N_PHASES = 22;

template <int KIND> __global__ void __launch_bounds__(NTHR, 2) trunk_k(Args args) {
    extern __shared__ __attribute__((aligned(16))) unsigned char lds_raw[];
    Frame F;
    F.lds = (LAS unsigned char*)lds_raw;
    F.tid = threadIdx.x; F.lane = F.tid & 63; F.wave = __builtin_amdgcn_readfirstlane(F.tid >> 6);
    F.G = gridDim.x; { const int bx = blockIdx.x; F.vcu = (F.G % 8 == 0) ? (bx % 8) * (F.G / 8) + bx / 8 : bx; }
    const int vcu0 = F.vcu, wave0 = F.wave;
    F.in = args.in; F.out = args.out; F.ws = args.ws;
    volatile LAS unsigned* MISC = (volatile LAS unsigned*)(F.lds + MISC_OFF);
    if (F.tid < 64) MISC[F.tid] = 0u;
    __syncthreads();
    XcdBarrier bar; bar.bar = (unsigned*)(F.ws + WS_CTL) + CW_BAR; bar.x = 0; bar.st = nullptr;
    const bool one_launch = (args.ph_hi - args.ph_lo) > 1;
    if (one_launch) bar = xcd_barrier_post((unsigned*)(F.ws + WS_CTL) + CW_BAR, MISC + 8);

#define RELAUNDER() do { int l_ = lane_id(); asm volatile("" : "+v"(l_));     \
        int wv_ = wave0; asm volatile("" : "+s"(wv_)); F.lane = l_; F.wave = wv_; F.tid = wv_ * 64 + l_; \
        unsigned long long w_ = (unsigned long long)args.ws; asm volatile("" : "+s"(w_)); F.ws = (unsigned char*)(GAS unsigned char*)w_;     \
        int v_ = vcu0; asm volatile("" : "+s"(v_)); F.vcu = v_; } while (0)
#define WANT(kind) (KIND < 0 || KIND == (kind))
    unsigned long long pr_acc = 0ull, pr_t0 = 0ull;
#define PR_BEGIN(kind) do { if (DBG_PROBE == (kind)) pr_t0 = __builtin_amdgcn_s_memrealtime(); } while (0)
#define PR_END(kind) do { if (DBG_PROBE == (kind)) pr_acc += __builtin_amdgcn_s_memrealtime() - pr_t0; } while (0)
#define BARRIER() do { if (DBG_PROBE == 12) pr_t0 = __builtin_amdgcn_s_memrealtime(); xcd_barrier(bar, F.wave == 0 && lane_id() == 0); if (DBG_PROBE == 12) pr_acc += __builtin_amdgcn_s_memrealtime() - pr_t0; } while (0)
    if (WANT(10) && args.ph_lo == 0) {
        PR_BEGIN(10);
        RELAUNDER();
        mods_phase(F, F.in[I_C], F.in[I_WADA], F.in[I_BADA], (float*)(F.ws + WS_MOD));
        rope_phase(F, (const int*)F.in[I_POS], (float*)(F.ws + WS_ROPE));
        convert_weights(F, 0, 0);
        if (((DBG_REPEAT) >> 10) & 1) { xcd_barrier(bar, F.wave == 0 && lane_id() == 0); RELAUNDER();
            mods_phase(F, F.in[I_C], F.in[I_WADA], F.in[I_BADA], (float*)(F.ws + WS_MOD)); rope_phase(F, (const int*)F.in[I_POS], (float*)(F.ws + WS_ROPE)); convert_weights(F, 0, 0); }
        if (args.ph_hi > 1) BARRIER();
        PR_END(10);
    }
    const int lo = args.ph_lo < 1 ? 1 : args.ph_lo, hi = args.ph_hi > N_PHASES - 1 ? N_PHASES - 1 : args.ph_hi;
    for (int ph = lo; ph < hi; ++ph) {
        const int l = (ph - 1) / 10, k = (ph - 1) % 10;
        if (KIND >= 0 && k != KIND) continue;
        const bool idem = (k == 1 || k == 2 || k == 4 || k == 6 || k == 7 || k == 8 || k == 9) || (l == 0 && (k == 0 || k == 5));
        const int reps = (((DBG_REPEAT) >> k) & 1) && idem ? 2 : 1;
        if (DBG_PROBE == k) pr_t0 = __builtin_amdgcn_s_memrealtime();
        for (int rep = 0; rep < reps; ++rep) {
        RELAUNDER();
        bf16_t* P = (bf16_t*)(F.ws + WS_PROJ);
        const size_t PB = (size_t)T * 1024;
        if (k == 0) { if (l > 0) convert_weights(F, l, 0); rp1_phase(F, l); }
        else if (k == 1) { DenseOrder<32> S{(const bf16_t*)(F.ws + WS_H), (const bf16_t*)(F.ws + WT_IN), (int)blockIdx.x}; EpiG1 E{P};
            pg8::gemm_phase<EpiG1, DenseOrder<32>, true, true>(F.lds, F.tid, 1024, S, E); }
        else if (k == 2) { mix::ms_phase(F, l, pr_acc); }
        else if (k == 3) { mix::m2_phase(F, l, pr_acc); }
        else if (k == 4) { BranchOrder S{P + PH_MV * PB, P + PH_RV * PB, (const bf16_t*)(F.ws + WT_BM), (const bf16_t*)(F.ws + WT_BR), (int)blockIdx.x};
            EpiBr E{P + PH_GA * PB, P + PH_GB * PB, (float*)(F.ws + WS_T1), (bf16_t*)(F.ws + WS_Y)};
            pg8::gemm_phase<EpiBr, BranchOrder, true, true>(F.lds, F.tid, 1024, S, E); }
        else if (k == 5) { DenseOrder<4> S{(const bf16_t*)(F.ws + WS_Y), (const bf16_t*)(F.ws + WT_OUT), (int)blockIdx.x};
            EpiOut E{l == 0 ? F.in[I_X] : F.out, F.out, (const float*)(F.ws + WS_MOD) + (size_t)l * 8 * 6144};
            pg8::gemm_phase<EpiOut, DenseOrder<4>, true, true>(F.lds, F.tid, 1024, S, E); }
        else if (k == 6) { convert_weights(F, l, 1); rp2_phase(F, l, reps == 2 && rep == 0); }
        else if (k == 7) { gather_phase(F, l); }
        else if (k == 8) { MoeOrder S{(const bf16_t*)(F.ws + WS_HS), (const bf16_t*)(F.ws + WT_GU), (size_t)1024 * 1024, (const unsigned*)(F.ws + WS_CTL) + CW_CNT + 64 * l, (int)blockIdx.x};
            EpiGU E{(bf16_t*)(F.ws + WS_HE)};
            pg8::gemm_phase<EpiGU, MoeOrder, true, true>(F.lds, F.tid, 1024, S, E); }
        else { MoeOrder S{(const bf16_t*)(F.ws + WS_HE), (const bf16_t*)(F.ws + WT_DN), (size_t)1024 * DFF, (const unsigned*)(F.ws + WS_CTL) + CW_CNT + 64 * l, (int)blockIdx.x};
            EpiDN E{(const int*)(F.ws + WS_LIST), (const float*)(F.ws + WS_WTS), (bf16_t*)(F.ws + WS_O2)};
            pg8::gemm_phase<EpiDN, MoeOrder, true, true>(F.lds, F.tid, DFF, S, E); }
        if (rep + 1 < reps) xcd_barrier(bar, F.wave == 0 && lane_id() == 0);
        }
        if (ph + 1 < args.ph_hi) BARRIER();
        if (DBG_PROBE == k) pr_acc += __builtin_amdgcn_s_memrealtime() - pr_t0;
    }
    if (WANT(11) && args.ph_hi == N_PHASES) { PR_BEGIN(11); RELAUNDER(); final_phase(F); VM_WAIT(); PR_END(11); }
    if (DBG_PROBE >= 0 && blockIdx.x == 0) { const unsigned long long t1 = __builtin_amdgcn_s_memrealtime();
        while (__builtin_amdgcn_s_memrealtime() - t1 < 8ull * pr_acc) __builtin_amdgcn_s_sleep(8); }
#undef PR_BEGIN
#undef PR_END
#undef BARRIER
#undef RELAUNDER
#undef WANT
}

typedef void (*KernFn)(Args);
template <int K> static KernFn kern_of() { return trunk_k<K>; }
static KernFn kind_fn(int kind) {
    switch (kind) { case 0: return kern_of<0>(); case 1: return kern_of<1>(); case 2: return kern_of<2>(); case 3: return kern_of<3>(); case 4: return kern_of<4>(); case 5: return kern_of<5>();
                    case 6: return kern_of<6>(); case 7: return kern_of<7>(); case 8: return kern_of<8>(); case 9: return kern_of<9>(); case 10: return kern_of<10>(); default: return kern_of<11>(); }
}
extern "C" void kernel_launch(void* const* d_in, const int* in_sizes, int n_in, void* d_out, int out_size, void* d_ws, size_t ws_size, hipStream_t stream) {
    static int grid = 0;
    if (grid == 0) {
        if (n_in != N_IN || out_size != T * D || ws_size < WS_END) { fprintf(stderr, "kernel_launch: unexpected shapes (n_in %d, out %d, ws %zu; need ws >= %zu)\n", n_in, out_size, ws_size, (size_t)WS_END); grid = -1; return; }
        int dev = 0, cus = 0, per_cu = 0;
        if (hipGetDevice(&dev) != hipSuccess || hipDeviceGetAttribute(&cus, hipDeviceAttributeMultiprocessorCount, dev) != hipSuccess) { grid = -1; return; }
#if MK_N_LAUNCHES == 1
        if (hipFuncSetAttribute((const void*)trunk_k<-1>, hipFuncAttributeMaxDynamicSharedMemorySize, LDS_BYTES) != hipSuccess) { fprintf(stderr, "kernel_launch: hipFuncSetAttribute failed\n"); grid = -1; return; }
        if (hipOccupancyMaxActiveBlocksPerMultiprocessor(&per_cu, (const void*)trunk_k<-1>, NTHR, LDS_BYTES) != hipSuccess || per_cu < 1) { fprintf(stderr, "kernel_launch: occupancy query says %d\n", per_cu); (void)hipGetLastError(); grid = -1; return; }
#else
        for (int k = 0; k < 12; ++k) if (hipFuncSetAttribute((const void*)kind_fn(k), hipFuncAttributeMaxDynamicSharedMemorySize, LDS_BYTES) != hipSuccess) { fprintf(stderr, "kernel_launch: hipFuncSetAttribute failed\n"); grid = -1; return; }
        per_cu = 1;
#endif
        if (cus != GRID) { fprintf(stderr, "kernel_launch: %d CUs; this build needs exactly %d\n", cus, GRID); grid = -1; return; }
        grid = cus;
    }
    if (grid < 0) return;
    (void)hipMemsetAsync((char*)d_ws + WS_CTL, 0, CTL_ZERO_BYTES, stream);
    Args a{};
    for (int i = 0; i < N_IN; ++i) a.in[i] = (const float*)d_in[i];
    a.out = (float*)d_out; a.ws = (unsigned char*)d_ws;
#if MK_N_LAUNCHES == 1
    a.ph_lo = 0; a.ph_hi = N_PHASES;
    void* kargs[] = {&a};
    hipError_t e = hipLaunchCooperativeKernel((const void*)trunk_k<-1>, dim3(grid), dim3(NTHR), kargs, LDS_BYTES, stream);
    if (e != hipSuccess) fprintf(stderr, "kernel_launch: cooperative launch failed: %s\n", hipGetErrorString(e));
#else
    for (int ph = 0; ph < N_PHASES; ++ph) { a.ph_lo = ph; a.ph_hi = ph + 1; const int kind = ph == 0 ? 10 : ph == N_PHASES - 1 ? 11 : (ph - 1) % 10;
        hipLaunchKernelGGL(kind_fn(kind), dim3(grid), dim3(NTHR), LDS_BYTES, stream, a); }
#endif
}
```
